# Optimizing an MI355X kernel written in HIP

```python
import jax, jax.numpy as jnp
from jax import lax
import numpy as np

D_MODEL = 2048
BATCH = 2
SEQ = 4096
DEPTH = 1

HEAD_DIM = 64
A_Q_HEADS = 12
A_KV_HEADS = 4
A_GROUP = A_Q_HEADS // A_KV_HEADS
WINDOW = 128
BLOCK = 128
B_HEADS = 12
C_HEADS = 4
C_HEAD_DIM = 128
MEM_TOKENS = 256
N_BRANCHES = 3
A_WIDTH = A_Q_HEADS * HEAD_DIM
A_KV_WIDTH = A_KV_HEADS * HEAD_DIM
B_WIDTH = B_HEADS * HEAD_DIM
C_WIDTH = C_HEADS * C_HEAD_DIM
EPS = 1e-6
NEG = -1e30

IN_SIZES = (A_WIDTH, A_KV_WIDTH, A_KV_WIDTH, A_WIDTH,
            B_WIDTH, B_WIDTH, B_WIDTH, B_WIDTH, B_HEADS,
            C_WIDTH, C_WIDTH,
            N_BRANCHES * D_MODEL)
IN_WIDTH = sum(IN_SIZES)
IN_OFFSETS = tuple(int(o) for o in np.cumsum(IN_SIZES)[:-1])

kernel_name = "hybrid_swa_fox_memory_gated_block"


def rms_norm(x, gain):
    x32 = x.astype(jnp.float32)
    y = x32 * lax.rsqrt(jnp.mean(x32 * x32, axis=-1, keepdims=True) + EPS)
    return (y * gain.astype(jnp.float32)).astype(x.dtype)


def alibi_slopes(n_heads):
    h = jnp.arange(1, n_heads + 1, dtype=jnp.float32)
    return jnp.exp2(-8.0 * h / n_heads)


def sliding_window_attention(q, k, v, q_gain, k_gain, sinks):
    b, s, _, d = q.shape
    nb = s // BLOCK
    q = rms_norm(q, q_gain).astype(jnp.float32)
    k = rms_norm(k, k_gain).astype(jnp.float32)
    v = v.astype(jnp.float32)
    qb = q.reshape(b, nb, BLOCK, A_KV_HEADS, A_GROUP, d)
    pad = jnp.zeros((b, BLOCK, A_KV_HEADS, d), jnp.float32)
    kp = jnp.concatenate([pad, k], axis=1).reshape(b, nb + 1, BLOCK, A_KV_HEADS, d)
    vp = jnp.concatenate([pad, v], axis=1).reshape(b, nb + 1, BLOCK, A_KV_HEADS, d)
    kb = jnp.concatenate([kp[:, :-1], kp[:, 1:]], axis=2)
    vb = jnp.concatenate([vp[:, :-1], vp[:, 1:]], axis=2)
    scores = jnp.einsum('bnqkgd,bnskd->bnkgqs', qb, kb) * (d ** -0.5)
    qi = jnp.arange(BLOCK)[:, None]
    kj = jnp.arange(2 * BLOCK)[None, :]
    rel = qi + BLOCK - kj
    key_pos = jnp.arange(nb)[:, None, None] * BLOCK - BLOCK + kj[None]
    valid = (rel >= 0) & (rel < WINDOW) & (key_pos >= 0)
    slopes = alibi_slopes(A_Q_HEADS).reshape(A_KV_HEADS, A_GROUP)
    bias = -slopes[:, :, None, None] * rel.astype(jnp.float32)
    scores = jnp.where(valid[None, :, None, None], scores + bias[None, None], NEG)
    sink = sinks.astype(jnp.float32).reshape(A_KV_HEADS, A_GROUP)[None, None, :, :, None, None]
    m = jnp.maximum(jnp.max(scores, axis=-1, keepdims=True), sink)
    p = jnp.exp(scores - m)
    denom = jnp.sum(p, axis=-1, keepdims=True) + jnp.exp(sink - m)
    out = jnp.einsum('bnkgqs,bnskd->bnqkgd', p / denom, vb)
    return out.reshape(b, s, A_Q_HEADS * d)


def forgetting_attention(q, k, v, f_logit, q_gain, k_gain):
    b, s, h, d = q.shape
    nb = s // BLOCK
    q = rms_norm(q, q_gain).astype(jnp.float32)
    k = rms_norm(k, k_gain).astype(jnp.float32)
    v = v.astype(jnp.float32)
    log_f = jax.nn.log_sigmoid(f_logit.astype(jnp.float32))
    c = jnp.cumsum(log_f, axis=1).transpose(0, 2, 1)
    q_blocks = q.reshape(b, nb, BLOCK, h, d).transpose(1, 0, 2, 3, 4)
    cq_blocks = c.reshape(b, h, nb, BLOCK).transpose(2, 0, 1, 3)
    key_pos = jnp.arange(s)
    scale = d ** -0.5

    def block_fn(args):
        qb, cqb, n = args
        sc = jnp.einsum('bqhd,bshd->bhqs', qb, k) * scale + cqb[..., None] - c[:, :, None, :]
        qpos = n * BLOCK + jnp.arange(BLOCK)
        mask = key_pos[None, :] <= qpos[:, None]
        sc = jnp.where(mask[None, None], sc, NEG)
        p = jax.nn.softmax(sc, axis=-1)
        return jnp.einsum('bhqs,bshd->bqhd', p, v)

    out = lax.map(block_fn, (q_blocks, cq_blocks, jnp.arange(nb)))
    return out.transpose(1, 0, 2, 3, 4).reshape(b, s, h * d)


def memory_attention(q, mk, mv, q_gain, k_gain):
    b, s, h, d = q.shape
    q = rms_norm(q, q_gain).astype(jnp.float32)
    mk = rms_norm(mk, k_gain).astype(jnp.float32)
    sc = jnp.einsum('bthd,bmhd->bhtm', q, mk) * (d ** -0.5)
    p = jax.nn.softmax(sc, axis=-1)
    out = jnp.einsum('bhtm,bmhd->bthd', p, mv.astype(jnp.float32))
    return out.reshape(b, s, h * d)


def hybrid_layer(x, mem, norm_gain, mem_norm_gain, w_in, b_forget,
                 q_gain_a, k_gain_a, sinks_a, q_gain_b, k_gain_b, q_gain_c, k_gain_c,
                 w_mem_kv, w_branch_a, w_branch_b, w_branch_c, w_out):
    b, s, _ = x.shape
    hn = rms_norm(x, norm_gain)
    proj = hn @ w_in
    (qa, ka, va, za, qb, kb, vb, zb, fb, qc, zc, gate_logits) = jnp.split(proj, IN_OFFSETS, axis=-1)

    ya = sliding_window_attention(qa.reshape(b, s, A_Q_HEADS, HEAD_DIM),
                                  ka.reshape(b, s, A_KV_HEADS, HEAD_DIM),
                                  va.reshape(b, s, A_KV_HEADS, HEAD_DIM),
                                  q_gain_a, k_gain_a, sinks_a).astype(x.dtype)
    ua = (ya * jax.nn.silu(za)) @ w_branch_a

    yb = forgetting_attention(qb.reshape(b, s, B_HEADS, HEAD_DIM),
                              kb.reshape(b, s, B_HEADS, HEAD_DIM),
                              vb.reshape(b, s, B_HEADS, HEAD_DIM),
                              fb + b_forget, q_gain_b, k_gain_b).astype(x.dtype)
    ub = (yb * jax.nn.silu(zb)) @ w_branch_b

    mkv = rms_norm(mem, mem_norm_gain) @ w_mem_kv
    mk, mv = jnp.split(mkv, 2, axis=-1)
    mlen = mem.shape[1]
    yc = memory_attention(qc.reshape(b, s, C_HEADS, C_HEAD_DIM),
                          mk.reshape(b, mlen, C_HEADS, C_HEAD_DIM),
                          mv.reshape(b, mlen, C_HEADS, C_HEAD_DIM),
                          q_gain_c, k_gain_c).astype(x.dtype)
    uc = (yc * jax.nn.silu(zc)) @ w_branch_c

    g = jax.nn.sigmoid(gate_logits.reshape(b, s, N_BRANCHES, D_MODEL))
    y = g[:, :, 0] * ua + g[:, :, 1] * ub + g[:, :, 2] * uc
    return x + y @ w_out


def setup_inputs(seed: int = 0) -> dict:
    key = jax.random.key(seed)
    ks = jax.random.split(key, 20)
    f32 = jnp.float32
    nrm = lambda k, shape: jax.random.normal(k, shape, f32)
    return {
        "x": nrm(ks[0], (BATCH, SEQ, D_MODEL)),
        "mem": nrm(ks[1], (BATCH, MEM_TOKENS, D_MODEL)),
        "norm_gain": 1.0 + 0.02 * nrm(ks[2], (DEPTH, D_MODEL)),
        "mem_norm_gain": 1.0 + 0.02 * nrm(ks[3], (DEPTH, D_MODEL)),
        "w_in": nrm(ks[4], (DEPTH, D_MODEL, IN_WIDTH)) * D_MODEL ** -0.5,
        "b_forget": 3.0 + 0.5 * nrm(ks[5], (DEPTH, B_HEADS)),
        "q_gain_a": 1.0 + 0.02 * nrm(ks[6], (DEPTH, HEAD_DIM)),
        "k_gain_a": 1.0 + 0.02 * nrm(ks[7], (DEPTH, HEAD_DIM)),
        "sinks_a": 0.5 * nrm(ks[8], (DEPTH, A_Q_HEADS)),
        "q_gain_b": 1.0 + 0.02 * nrm(ks[9], (DEPTH, HEAD_DIM)),
        "k_gain_b": 1.0 + 0.02 * nrm(ks[10], (DEPTH, HEAD_DIM)),
        "q_gain_c": 1.0 + 0.02 * nrm(ks[11], (DEPTH, C_HEAD_DIM)),
        "k_gain_c": 1.0 + 0.02 * nrm(ks[12], (DEPTH, C_HEAD_DIM)),
        "w_mem_kv": nrm(ks[13], (DEPTH, D_MODEL, 2 * C_WIDTH)) * D_MODEL ** -0.5,
        "w_branch_a": nrm(ks[14], (DEPTH, A_WIDTH, D_MODEL)) * A_WIDTH ** -0.5,
        "w_branch_b": nrm(ks[15], (DEPTH, B_WIDTH, D_MODEL)) * B_WIDTH ** -0.5,
        "w_branch_c": nrm(ks[16], (DEPTH, C_WIDTH, D_MODEL)) * C_WIDTH ** -0.5,
        "w_out": nrm(ks[17], (DEPTH, D_MODEL, D_MODEL)) * D_MODEL ** -0.5,
    }


def reference(x, mem, norm_gain, mem_norm_gain, w_in, b_forget,
              q_gain_a, k_gain_a, sinks_a, q_gain_b, k_gain_b, q_gain_c, k_gain_c,
              w_mem_kv, w_branch_a, w_branch_b, w_branch_c, w_out):
    for layer in range(DEPTH):
        x = hybrid_layer(x, mem, norm_gain[layer], mem_norm_gain[layer], w_in[layer], b_forget[layer],
                         q_gain_a[layer], k_gain_a[layer], sinks_a[layer],
                         q_gain_b[layer], k_gain_b[layer], q_gain_c[layer], k_gain_c[layer],
                         w_mem_kv[layer], w_branch_a[layer], w_branch_b[layer], w_branch_c[layer],
                         w_out[layer])
    return x
```

```cpp
#include <hip/hip_runtime.h>
#include <cstdint>
#include <cstdio>

constexpr int BATCH = 2, SEQ = 4096, DM = 2048, M = BATCH * SEQ;
constexpr int MEMT = 256, MM = BATCH * MEMT;
constexpr int IN_W = 12300;
constexpr int NP = 12288;
constexpr int PC_QA = 0, PC_KA = 768, PC_VA = 1024, PC_ZA = 1280, PC_QB = 2048, PC_KB = 2816, PC_VB = 3584, PC_ZB = 4352, PC_QC = 5120, PC_ZC = 5632, PC_G = 6144;
constexpr int SRC_FB = 5120;
constexpr float LOG2E = 1.4426950408889634f;
constexpr float C2_64 = 0.125f * LOG2E;
constexpr float C2_128 = 0.08838834764831845f * LOG2E;
constexpr float EPS = 1e-6f;

constexpr size_t MiB = 1u << 20;
constexpr size_t WS_CTL = 0, WS_CS2 = 1 * MiB, WS_LF = 1 * MiB + 512 * 1024, WS_MEMN = 2 * MiB, WS_MKV = 4 * MiB, WS_WMKVT = 6 * MiB, WS_WBRT = 10 * MiB, WS_WOUTT = 18 * MiB,
                 WS_HN = 26 * MiB, WS_W1T = 58 * MiB, WS_P = 106 * MiB, WS_END = 298 * MiB;
constexpr size_t WS_Y = WS_HN;
constexpr size_t WS_U = WS_W1T;

typedef unsigned short bf16;
__device__ __forceinline__ unsigned f2bf(float f) { unsigned u = __builtin_bit_cast(unsigned, f); return (u + 0x7fffu + ((u >> 16) & 1u)) >> 16; }
__device__ __forceinline__ float bf2f(unsigned short h) { return __builtin_bit_cast(float, (unsigned)h << 16); }
__device__ __forceinline__ float wave_sum(float v) {
#pragma unroll
    for (int o = 1; o < 64; o <<= 1) v += __shfl_xor(v, o);
    return v;
}
__device__ __forceinline__ float sigmoidf_(float x) { return 1.f / (1.f + __expf(-x)); }
__device__ __forceinline__ float log_sigmoidf_(float x) { return fminf(x, 0.f) - log1pf(__expf(-fabsf(x))); }

__global__ void __launch_bounds__(256) n_rmsnorm(const float* __restrict__ x, const float* __restrict__ gain, bf16* __restrict__ out, const float* __restrict__ w_in, const float* __restrict__ b_forget, float* __restrict__ LF) {
    __shared__ float red[4][16];
    const int row = blockIdx.x, tid = threadIdx.x, lane = tid & 63, w = tid >> 6;
    const float* xr = x + (size_t)row * DM;
    float v[8]; float s = 0.f;
#pragma unroll
    for (int j = 0; j < 8; ++j) { v[j] = xr[tid + 256 * j]; s += v[j] * v[j]; }
    s = wave_sum(s); if (lane == 0) red[w][0] = s; __syncthreads();
    const float tot = red[0][0] + red[1][0] + red[2][0] + red[3][0];
    const float rstd = 1.f / sqrtf(tot * (1.f / DM) + EPS);
    __syncthreads();
    float fb[12];
#pragma unroll
    for (int h = 0; h < 12; ++h) fb[h] = 0.f;
#pragma unroll
    for (int j = 0; j < 8; ++j) { const int k = tid + 256 * j; const float hv = v[j] * rstd * gain[k]; out[(size_t)row * DM + k] = (bf16)f2bf(hv);
        if (w_in) {
#pragma unroll
            for (int h = 0; h < 12; ++h) fb[h] += hv * w_in[(size_t)k * IN_W + SRC_FB + h]; } }
    if (w_in) {
#pragma unroll
        for (int h = 0; h < 12; ++h) { const float t = wave_sum(fb[h]); if (lane == 0) red[w][h] = t; }
        __syncthreads();
        if (tid < 12) { const float fl = red[0][tid] + red[1][tid] + red[2][tid] + red[3][tid] + b_forget[tid]; const int b = row / SEQ, t = row % SEQ; LF[((size_t)b * 12 + tid) * SEQ + t] = log_sigmoidf_(fl); }
    }
}
__global__ void __launch_bounds__(256) n_cumsum(const float* __restrict__ LF, float* __restrict__ CS2) {
    __shared__ float part[256];
    const int bh = blockIdx.x, tid = threadIdx.x; const float* src = LF + (size_t)bh * SEQ + tid * 16; float* dst = CS2 + (size_t)bh * SEQ + tid * 16;
    float v[16]; float s = 0.f;
#pragma unroll
    for (int i = 0; i < 16; ++i) { s += src[i]; v[i] = s; }
    part[tid] = s; __syncthreads();
    if (tid == 0) { float a = 0.f; for (int i = 0; i < 256; ++i) { const float t = part[i]; part[i] = a; a += t; } }
    __syncthreads();
    const float off = part[tid];
#pragma unroll
    for (int i = 0; i < 16; ++i) dst[i] = (v[i] + off) * LOG2E;
}

struct NGemm { const bf16* A; int lda; const float* W0; const float* W1; const float* W2; int ldw; int K;
               bf16* Ob; float* Of; const float* X; const bf16* G; const float* g_qa; const float* g_ka; const float* g_qb; const float* g_kb; const float* g_kc; int pad; };
template <int MODE> __global__ void __launch_bounds__(256) n_gemm(NGemm g) {
    __shared__ float As[16][68], Bs[16][68], T[64][65];
    const int tid = threadIdx.x, ty = tid >> 4, tx = tid & 15;
    const int n0 = blockIdx.x * 64, m0 = blockIdx.y * 64;
    const int srcn0 = (MODE == 0 && n0 >= SRC_FB) ? n0 + 12 : n0;
    float acc[4][4], tot[4][4];
#pragma unroll
    for (int i = 0; i < 4; ++i)
#pragma unroll
        for (int j = 0; j < 4; ++j) { acc[i][j] = 0.f; tot[i][j] = 0.f; }
    const int ar = tid >> 2, ak = (tid & 3) * 4, bk = tid >> 4, bn = (tid & 15) * 4;
    for (int k0 = 0; k0 < g.K; k0 += 16) {
        const float* W = g.W0; int kk = k0;
        if (MODE == 2) { if (k0 >= 1536) { W = g.W2; kk = k0 - 1536; } else if (k0 >= 768) { W = g.W1; kk = k0 - 768; } }
        if (MODE == 2 && (k0 == 768 || k0 == 1536)) {
            const int gi = (k0 == 768) ? 0 : 1;
#pragma unroll
            for (int i = 0; i < 4; ++i)
#pragma unroll
                for (int j = 0; j < 4; ++j) { const float gv = bf2f(g.G[(size_t)(m0 + ty * 4 + i) * NP + PC_G + gi * 2048 + n0 + tx * 4 + j]); tot[i][j] += gv * acc[i][j]; acc[i][j] = 0.f; }
        }
        { const bf16* ap = g.A + (size_t)(m0 + ar) * g.lda + k0 + ak;
#pragma unroll
          for (int i = 0; i < 4; ++i) As[ak + i][ar] = bf2f(ap[i]); }
        { const float* wp = W + (size_t)(kk + bk) * g.ldw + srcn0 + bn;
#pragma unroll
          for (int j = 0; j < 4; ++j) Bs[bk][bn + j] = wp[j]; }
        __syncthreads();
#pragma unroll
        for (int k = 0; k < 16; ++k) { float a[4], b[4];
#pragma unroll
            for (int i = 0; i < 4; ++i) { a[i] = As[k][ty * 4 + i]; b[i] = Bs[k][tx * 4 + i]; }
#pragma unroll
            for (int i = 0; i < 4; ++i)
#pragma unroll
                for (int j = 0; j < 4; ++j) acc[i][j] += a[i] * b[j]; }
        __syncthreads();
    }
    if (MODE == 2) {
#pragma unroll
        for (int i = 0; i < 4; ++i)
#pragma unroll
            for (int j = 0; j < 4; ++j) { const float gv = bf2f(g.G[(size_t)(m0 + ty * 4 + i) * NP + PC_G + 2 * 2048 + n0 + tx * 4 + j]); acc[i][j] = tot[i][j] + gv * acc[i][j]; }
    }
#pragma unroll
    for (int i = 0; i < 4; ++i)
#pragma unroll
        for (int j = 0; j < 4; ++j) T[ty * 4 + i][tx * 4 + j] = acc[i][j];
    __syncthreads();
    const int r = tid >> 2, c0 = (tid & 3) * 16, row = m0 + r;
    if (MODE == 0) {
        int mode = 0; const float* gain = nullptr; float sc = 1.f;
        if (n0 < PC_KA) { mode = 3; gain = g.g_qa; sc = C2_64; } else if (n0 < PC_VA) { mode = 3; gain = g.g_ka; } else if (n0 < PC_ZA) { mode = 0; } else if (n0 < PC_QB) { mode = 1; }
        else if (n0 < PC_KB) { mode = 3; gain = g.g_qb; sc = C2_64; } else if (n0 < PC_VB) { mode = 3; gain = g.g_kb; } else if (n0 < PC_ZB) { mode = 0; } else if (n0 < PC_QC) { mode = 1; }
        else if (n0 < PC_ZC) { mode = 0; } else if (n0 < PC_G) { mode = 1; } else { mode = 2; }
        float rs = 1.f;
        if (mode == 3) { float s = 0.f;
#pragma unroll
            for (int j = 0; j < 16; ++j) { const float v = T[r][c0 + j]; s += v * v; }
            s += __shfl_xor(s, 1); s += __shfl_xor(s, 2); rs = sc / sqrtf(s * (1.f / 64.f) + EPS); }
#pragma unroll
        for (int j = 0; j < 16; ++j) { float v = T[r][c0 + j];
            if (mode == 1) v = v * sigmoidf_(v); else if (mode == 2) v = sigmoidf_(v); else if (mode == 3) v = v * rs * gain[c0 + j];
            g.Ob[(size_t)row * NP + n0 + c0 + j] = (bf16)f2bf(v); }
    } else if (MODE == 1) {
#pragma unroll
        for (int j = 0; j < 16; ++j) g.Ob[(size_t)row * 1024 + n0 + c0 + j] = (bf16)f2bf(T[r][c0 + j]);
    } else if (MODE == 2) {
#pragma unroll
        for (int j = 0; j < 16; ++j) g.Ob[(size_t)row * DM + n0 + c0 + j] = (bf16)f2bf(T[r][c0 + j]);
    } else {
#pragma unroll
        for (int j = 0; j < 16; ++j) g.Of[(size_t)row * DM + n0 + c0 + j] = g.X[(size_t)row * DM + n0 + c0 + j] + T[r][c0 + j];
    }
}

__device__ __forceinline__ float wave_max(float v) {
#pragma unroll
    for (int o = 1; o < 64; o <<= 1) v = fmaxf(v, __shfl_xor(v, o));
    return v;
}
template <int KIND> __global__ void __launch_bounds__(256) n_attn(const bf16* __restrict__ P, const bf16* __restrict__ MKV, const float* __restrict__ CS2, const float* __restrict__ sinks,
                                                              const float* __restrict__ g_qc, const float* __restrict__ g_kc, bf16* __restrict__ U) {
    const int lane = threadIdx.x & 63, gw = blockIdx.x * 4 + (threadIdx.x >> 6);
    constexpr int NH = (KIND == 2) ? 4 : 12;
    const int row = gw / NH, h = gw % NH, b = row / SEQ, t = row % SEQ;
    if (KIND == 2) {
        const bf16* qp = P + (size_t)row * NP + PC_QC + h * 128; float q0 = bf2f(qp[lane]), q1 = bf2f(qp[64 + lane]);
        const float rq = C2_128 / sqrtf(wave_sum(q0 * q0 + q1 * q1) * (1.f / 128.f) + EPS); q0 *= rq * g_qc[lane]; q1 *= rq * g_qc[64 + lane];
        float m = -1e30f, l = 0.f, o0 = 0.f, o1 = 0.f;
        for (int s = 0; s < MEMT; ++s) { const bf16* kp = MKV + (size_t)(b * MEMT + s) * 1024 + h * 128; float k0 = bf2f(kp[lane]), k1 = bf2f(kp[64 + lane]);
            const float rk = 1.f / sqrtf(wave_sum(k0 * k0 + k1 * k1) * (1.f / 128.f) + EPS); k0 *= rk * g_kc[lane]; k1 *= rk * g_kc[64 + lane];
            const float sc = wave_sum(q0 * k0 + q1 * k1); const float mn = fmaxf(m, sc), al = exp2f(m - mn), p = exp2f(sc - mn);
            const bf16* vp = kp + 512; l = l * al + p; o0 = o0 * al + p * bf2f(vp[lane]); o1 = o1 * al + p * bf2f(vp[64 + lane]); m = mn; }
        const float il = 1.f / l; const bf16* zp = P + (size_t)row * NP + PC_ZC + h * 128; bf16* up = U + (size_t)row * DM + 1536 + h * 128;
        up[lane] = (bf16)f2bf(o0 * il * bf2f(zp[lane])); up[64 + lane] = (bf16)f2bf(o1 * il * bf2f(zp[64 + lane]));
    } else if (KIND == 0) {
        const float q = bf2f(P[(size_t)row * NP + PC_QA + h * 64 + lane]); const int kvh = h / 3;
        const float slope2 = exp2f(-8.f * (float)(h + 1) / 12.f) * LOG2E;
        float m = sinks[h] * LOG2E, l = 1.f, o = 0.f;
        const int s0 = t - 127 < 0 ? 0 : t - 127;
        for (int s = s0; s <= t; ++s) { const bf16* kp = P + (size_t)(b * SEQ + s) * NP + PC_KA + kvh * 64;
            const float sc = wave_sum(q * bf2f(kp[lane])) - slope2 * (float)(t - s); const float mn = fmaxf(m, sc), al = exp2f(m - mn), p = exp2f(sc - mn);
            l = l * al + p; o = o * al + p * bf2f(kp[PC_VA - PC_KA + lane]); m = mn; }
        U[(size_t)row * DM + h * 64 + lane] = (bf16)f2bf(o / l * bf2f(P[(size_t)row * NP + PC_ZA + h * 64 + lane]));
    } else {
        const float q = bf2f(P[(size_t)row * NP + PC_QB + h * 64 + lane]); const float* cs = CS2 + ((size_t)b * 12 + h) * SEQ; const float ct = cs[t];
        float m = -1e30f, l = 0.f, o = 0.f;
        for (int s = 0; s <= t; ++s) { const bf16* kp = P + (size_t)(b * SEQ + s) * NP + PC_KB + h * 64;
            const float sc = wave_sum(q * bf2f(kp[lane])) + (ct - cs[s]); const float mn = fmaxf(m, sc), al = exp2f(m - mn), p = exp2f(sc - mn);
            l = l * al + p; o = o * al + p * bf2f(kp[PC_VB - PC_KB + lane]); m = mn; }
        U[(size_t)row * DM + 768 + h * 64 + lane] = (bf16)f2bf(o / l * bf2f(P[(size_t)row * NP + PC_ZB + h * 64 + lane]));
    }
}

extern "C" void kernel_launch(void* const* d_in, const int* in_sizes, int n_in, void* d_out, int out_size, void* d_ws, size_t ws_size, hipStream_t stream) {
    if (n_in != 18 || in_sizes[0] != M * DM || out_size != M * DM || ws_size < WS_END) { fprintf(stderr, "kernel_launch: unexpected shapes (n_in %d, in0 %d, out %d, ws %zu)\n", n_in, n_in > 0 ? in_sizes[0] : -1, out_size, ws_size); return; }
    const float* x = (const float*)d_in[0]; const float* mem = (const float*)d_in[1]; const float* norm_gain = (const float*)d_in[2]; const float* mem_norm_gain = (const float*)d_in[3];
    const float* w_in = (const float*)d_in[4]; const float* b_forget = (const float*)d_in[5]; const float* q_gain_a = (const float*)d_in[6]; const float* k_gain_a = (const float*)d_in[7];
    const float* sinks_a = (const float*)d_in[8]; const float* q_gain_b = (const float*)d_in[9]; const float* k_gain_b = (const float*)d_in[10]; const float* q_gain_c = (const float*)d_in[11];
    const float* k_gain_c = (const float*)d_in[12]; const float* w_mem_kv = (const float*)d_in[13]; const float* w_br_a = (const float*)d_in[14]; const float* w_br_b = (const float*)d_in[15];
    const float* w_br_c = (const float*)d_in[16]; const float* w_out = (const float*)d_in[17];
    unsigned char* ws = (unsigned char*)d_ws; float* out = (float*)d_out;
    bf16* HN = (bf16*)(ws + WS_HN); bf16* MEMN = (bf16*)(ws + WS_MEMN); bf16* MKV = (bf16*)(ws + WS_MKV); bf16* P = (bf16*)(ws + WS_P); bf16* U = (bf16*)(ws + WS_U); bf16* Y = (bf16*)(ws + WS_Y);
    float* CS2 = (float*)(ws + WS_CS2); float* LF = (float*)(ws + WS_LF);

    n_rmsnorm<<<M, 256, 0, stream>>>(x, norm_gain, HN, w_in, b_forget, LF);
    n_rmsnorm<<<MM, 256, 0, stream>>>(mem, mem_norm_gain, MEMN, nullptr, nullptr, nullptr);
    n_cumsum<<<BATCH * 12, 256, 0, stream>>>(LF, CS2);
    { NGemm g{}; g.A = HN; g.lda = DM; g.W0 = w_in; g.ldw = IN_W; g.K = DM; g.Ob = P; g.g_qa = q_gain_a; g.g_ka = k_gain_a; g.g_qb = q_gain_b; g.g_kb = k_gain_b;
      n_gemm<0><<<dim3(NP / 64, M / 64), 256, 0, stream>>>(g); }
    { NGemm g{}; g.A = MEMN; g.lda = DM; g.W0 = w_mem_kv; g.ldw = 1024; g.K = DM; g.Ob = MKV;
      n_gemm<1><<<dim3(1024 / 64, MM / 64), 256, 0, stream>>>(g); }
    n_attn<0><<<M * 12 / 4, 256, 0, stream>>>(P, MKV, CS2, sinks_a, q_gain_c, k_gain_c, U);
    n_attn<1><<<M * 12 / 4, 256, 0, stream>>>(P, MKV, CS2, sinks_a, q_gain_c, k_gain_c, U);
    n_attn<2><<<M * 4 / 4, 256, 0, stream>>>(P, MKV, CS2, sinks_a, q_gain_c, k_gain_c, U);
    { NGemm g{}; g.A = U; g.lda = DM; g.W0 = w_br_a; g.W1 = w_br_b; g.W2 = w_br_c; g.ldw = DM; g.K = DM; g.Ob = Y; g.G = P;
      n_gemm<2><<<dim3(DM / 64, M / 64), 256, 0, stream>>>(g); }
    { NGemm g{}; g.A = Y; g.lda = DM; g.W0 = w_out; g.ldw = DM; g.K = DM; g.Of = out; g.X = x;
      n_gemm<3><<<dim3(DM / 64, M / 64), 256, 0, stream>>>(g); }
}
```

```cpp
#include <hip/hip_runtime.h>
#include <cstdint>
#include <cstdio>

constexpr int BATCH = 2, SEQ = 4096, DM = 2048, M = BATCH * SEQ;
constexpr int MEMT = 256, MM = BATCH * MEMT;
constexpr int IN_W = 12300;
constexpr int NP = 12288;
constexpr int PC_QA = 0, PC_KA = 768, PC_VA = 1024, PC_ZA = 1280, PC_QB = 2048, PC_KB = 2816, PC_VB = 3584, PC_ZB = 4352, PC_QC = 5120, PC_ZC = 5632, PC_G = 6144;
constexpr int PGW = 1024, PG_QC = 0, PG_ZC = 512;
constexpr int SRC_FB = 5120;
constexpr float LOG2E = 1.4426950408889634f;
constexpr float C2_64 = 0.125f * LOG2E;
constexpr float C2_128 = 0.08838834764831845f * LOG2E;
constexpr float EPS = 1e-6f;
constexpr float GATE_MIN = 1e-18f;

constexpr size_t MiB = 1u << 20;
constexpr size_t WS_CTL = 0, CTL_ZERO_BYTES = 1 * MiB, WS_CS2 = 1 * MiB, WS_LF = 1 * MiB + 512 * 1024, WS_MEMN = 2 * MiB, WS_MKV = 4 * MiB, WS_WMKVT = 6 * MiB, WS_WBRT = 10 * MiB, WS_WOUTT = 18 * MiB,
                 WS_HN = 26 * MiB, WS_W1T = 58 * MiB, WS_P = 106 * MiB, WS_END = 298 * MiB;
constexpr size_t WS_WFB = WS_CS2 + 393216;
constexpr size_t WS_T0 = WS_LF + 393216;
constexpr size_t WS_PG = WS_P, WS_QA = WS_P + 112 * MiB, WS_ZA = WS_QA + 12 * MiB, WS_QB = WS_ZA + 12 * MiB, WS_ZB = WS_QB + 12 * MiB, WS_KB = WS_ZB + 12 * MiB, WS_VB = WS_KB + 12 * MiB, WS_KA = WS_VB + 12 * MiB, WS_VA = WS_KA + 4 * MiB;
static_assert(WS_VA + 4 * MiB == WS_END, "ws map");
constexpr size_t WS_Y = WS_HN;
constexpr size_t WS_U = WS_W1T;

typedef unsigned short bf16;
__device__ __forceinline__ unsigned f2bf(float f) { unsigned u = __builtin_bit_cast(unsigned, f); return (u + 0x7fffu + ((u >> 16) & 1u)) >> 16; }
__device__ __forceinline__ float bf2f(unsigned short h) { return __builtin_bit_cast(float, (unsigned)h << 16); }
__device__ __forceinline__ unsigned pk2(float lo, float hi) { typedef float f2_ __attribute__((ext_vector_type(2))); typedef __bf16 b2_ __attribute__((ext_vector_type(2))); f2_ v = {lo, hi}; b2_ b = __builtin_convertvector(v, b2_); return __builtin_bit_cast(unsigned, b); }
__device__ __forceinline__ float wave_sum(float v) {
#pragma unroll
    for (int o = 1; o < 64; o <<= 1) v += __shfl_xor(v, o);
    return v;
}
__device__ __forceinline__ float sigmoidf_(float x) { return 1.f / (1.f + __expf(-x)); }
__device__ __forceinline__ float log_sigmoidf_(float x) { return fminf(x, 0.f) - log1pf(__expf(-fabsf(x))); }
__device__ __forceinline__ float fast_sigmoid(float v) { return __builtin_amdgcn_rcpf(1.f + __builtin_amdgcn_exp2f(-LOG2E * v)); }

#ifndef P3_ROT
#define P3_ROT 0
#endif
namespace pg8 {
#define PG8_LAS __attribute__((address_space(3)))
typedef unsigned short bf16_t;
typedef short bf16x8 __attribute__((ext_vector_type(8)));
typedef float f32x4 __attribute__((ext_vector_type(4)));
typedef unsigned u32x4 __attribute__((ext_vector_type(4)));
constexpr int BM = 256, BK = 64, HALF = 128, HTB = HALF * BK * 2  , STAGE_BYTES = 8 * HTB, NXCD = 8, WGM = 8;

__host__ __device__ __forceinline__ int lds_byte(int r, int c) { const int st = (r >> 4) * 2 + (c >> 5), rr = r & 15, cc = c & 31, ob = rr * 64 + cc * 2; return st * 1024 + (ob ^ (((ob >> 9) & 1) << 5)); }
__host__ __device__ __forceinline__ void stage_rc(int b, int& R, int& C) { const int st = b / 1024, sb = b % 1024, swz = sb ^ (((sb >> 9) & 1) << 5); R = (st >> 1) * 16 + swz / 64; C = (st & 1) * 32 + (swz % 64) / 2; }
__host__ __device__ __forceinline__ int perm32(int rho) { const int n = rho >> 4, i = rho & 15; return 8 * (i >> 2) + 4 * n + (i & 3); }

struct Unit { int pm, pn, rot; };
struct Gemm { const bf16_t* A; const bf16_t* Bt; int M, N, K; };

struct StaticOrder {
    int nM, nN, nwg, G, c, rep, wgm;
    __host__ __device__ void init(int M, int N, int G_, int c_) { nM = M / BM; nN = N / BM; nwg = nM * nN; G = G_; c = c_; rep = 1; wgm = WGM; }
    __host__ __device__ bool next(int i, Unit& u) const {
        const int rounds = (nwg + G - 1) / G; if (i >= rounds * rep) return false; i = i % rounds;
        const long L = (long)i * G + c; if (L >= nwg) return false;
        int wgid = (int)L; { const int q = nwg / NXCD, r = nwg % NXCD, xcd = wgid % NXCD, off = wgid / NXCD; wgid = (xcd < r ? xcd * (q + 1) : r * (q + 1) + (xcd - r) * q) + off; }
        const int nig = wgm * nN, gid = wgid / nig, fm = gid * wgm, gsz = (nM - fm) < wgm ? (nM - fm) : wgm;
        u.pm = fm + ((wgid % nig) % gsz); u.pn = (wgid % nig) / gsz; u.rot = 0; return true;
    }
    __device__ __forceinline__ void a_ready(const Unit&) const {}
    __device__ __forceinline__ void done(const Unit&) const {}
};

struct SingleOrder { int pm, pn;
    __device__ __forceinline__ bool next(int i, Unit& u) const { if (i != 0) return false; u.pm = pm; u.pn = pn; u.rot = 0; return true; }
    __device__ __forceinline__ void a_ready(const Unit&) const {}
    __device__ __forceinline__ void done(const Unit&) const {}
};
__device__ __forceinline__ unsigned cvt_pk_bf16(float lo, float hi) { unsigned r; asm volatile("v_cvt_pk_bf16_f32 %0, %1, %2" : "=v"(r) : "v"(lo), "v"(hi)); return r; }
typedef float f32x2 __attribute__((ext_vector_type(2)));

__device__ __forceinline__ f32x4 bf4_lo(unsigned a, unsigned b) { return (f32x4){__builtin_bit_cast(float, a << 16), __builtin_bit_cast(float, a & 0xffff0000u), __builtin_bit_cast(float, b << 16), __builtin_bit_cast(float, b & 0xffff0000u)}; }
__device__ __forceinline__ u32x4 pack8(const f32x4 v0, const f32x4 v1) { u32x4 w; w.x = cvt_pk_bf16(v0[0], v0[1]); w.y = cvt_pk_bf16(v0[2], v0[3]); w.z = cvt_pk_bf16(v1[0], v1[1]); w.w = cvt_pk_bf16(v1[2], v1[3]); return w; }
__device__ __forceinline__ float sigm(float v) { return __builtin_amdgcn_rcpf(1.f + __builtin_amdgcn_exp2f(-1.4426950408889634f * v)); }

struct EpiProj {
    static constexpr bool PERM = true, AFTER_DRAIN = false, HEADPERM = true, MIDHOOK = false;
    bf16_t* PG; bf16_t* QA; bf16_t* ZA; bf16_t* QB; bf16_t* ZB; bf16_t* KB; bf16_t* VB; bf16_t* KA; bf16_t* VA;
    const float* g_qa; const float* g_ka; const float* g_qb; const float* g_kb; float qscale; float eps; float gate_min;
    static constexpr int G_OFF = 8192 * 1024;
    __device__ __forceinline__ void operator()(const f32x4 (&acc)[2][2][4][2], const Unit& u, int wr, int wc, int fr, int fq) const {
        const int pn = u.pn; int mode = 0; const float* gain = g_qa; float sc = 1.f;
        int lay = 0; bf16_t* dst = PG; int head = 0, nh = 12, pgcol = 0;
        if (pn < 3) { mode = 3; gain = g_qa; sc = qscale; lay = 1; dst = QA; head = pn * 4 + wc; } else if (pn < 4) { mode = 3; gain = g_ka; lay = 2; dst = KA; head = wc; nh = 4; }
        else if (pn < 5) { mode = 0; lay = 3; dst = VA; head = wc; nh = 4; } else if (pn < 8) { mode = 1; lay = 1; dst = ZA; head = (pn - 5) * 4 + wc; }
        else if (pn < 11) { mode = 3; gain = g_qb; sc = qscale; lay = 1; dst = QB; head = (pn - 8) * 4 + wc; } else if (pn < 14) { mode = 3; gain = g_kb; lay = 2; dst = KB; head = (pn - 11) * 4 + wc; }
        else if (pn < 17) { mode = 0; lay = 3; dst = VB; head = (pn - 14) * 4 + wc; } else if (pn < 20) { mode = 1; lay = 1; dst = ZB; head = (pn - 17) * 4 + wc; }
        else if (pn < 22) { mode = 0; pgcol = (pn - 20) * BM; } else if (pn < 24) { mode = 1; pgcol = 512 + (pn - 22) * BM; } else { mode = 2; lay = 4; }
        const int row0 = u.pm * BM + wr * 64 + fr;
        f32x4 gv[2][2];
#pragma unroll
        for (int bj = 0; bj < 2; ++bj)
#pragma unroll
            for (int n = 0; n < 2; ++n) gv[bj][n] = (mode == 3) ? *(const f32x4*)(gain + 32 * bj + 8 * fq + 4 * n) : (f32x4){1.f, 1.f, 1.f, 1.f};
#pragma unroll
        for (int ai = 0; ai < 2; ++ai)
#pragma unroll
            for (int m = 0; m < 4; ++m) { const int row = row0 + ai * HALF + m * 16, b = row >> 12, t = row & 4095;
                size_t o0, o1;
                if (lay == 4) {
                    const int gi = (pn - 24) >> 3, ct = (pn - 24) & 7;
                    o0 = (size_t)G_OFF + ((((size_t)(u.pm * 8 + ct) * 3 + gi) * 8 + (wr * 4 + wc)) * 16 + (ai * 8 + m * 2)) * 512 + (size_t)(fq * 16 + fr) * 8; o1 = o0 + 512; }
                else if (lay == 0) { o0 = (size_t)row * 1024 + pgcol + wc * 64 + 8 * fq; o1 = o0 + 32; }
                else if (lay == 1) { o0 = ((size_t)(b * 12 + head) * 4096 + t) * 64 + 8 * fq; o1 = o0 + 32; }
                else if (lay == 2) { o0 = ((size_t)(b * nh + head) * 64 + (t >> 6)) * 4096 + fq * 512 + (t & 63) * 8; o1 = o0 + 4 * 512; }
                else { o0 = ((size_t)(b * nh + head) * 64 + (t >> 6)) * 4096 + (t & 63) * 32 + fq * 8; o1 = o0 + 2048; }
                float rs = 1.f;
                if (mode == 3) { float s = 0.f;
#pragma unroll
                    for (int bj = 0; bj < 2; ++bj)
#pragma unroll
                        for (int n = 0; n < 2; ++n) { const f32x4 x = acc[ai][bj][m][n]; s += (x[0] * x[0] + x[1] * x[1]) + (x[2] * x[2] + x[3] * x[3]); }
                    s += __shfl_xor(s, 16); s += __shfl_xor(s, 32);
                    rs = sc * __builtin_amdgcn_rsqf(s * (1.f / 64.f) + eps); }
#pragma unroll
                for (int bj = 0; bj < 2; ++bj) { f32x4 v0 = acc[ai][bj][m][0], v1 = acc[ai][bj][m][1];
                    if (mode == 3) { v0 = v0 * rs * gv[bj][0]; v1 = v1 * rs * gv[bj][1]; }
                    else if (mode == 1) {
#pragma unroll
                        for (int j = 0; j < 4; ++j) { v0[j] = v0[j] * sigm(v0[j]); v1[j] = v1[j] * sigm(v1[j]); } }
                    else if (mode == 2) {
#pragma unroll
                        for (int j = 0; j < 4; ++j) { v0[j] = __builtin_fmaxf(sigm(v0[j]), gate_min); v1[j] = __builtin_fmaxf(sigm(v1[j]), gate_min); } }
                    *(u32x4*)(dst + (bj == 0 ? o0 : o1)) = pack8(v0, v1); } }
    }
};
struct EpiPlain {
    static constexpr bool PERM = true, AFTER_DRAIN = false, HEADPERM = true, MIDHOOK = false;
    bf16_t* O; int ldc;
    __device__ __forceinline__ void operator()(const f32x4 (&acc)[2][2][4][2], const Unit& u, int wr, int wc, int fr, int fq) const {
        const int row0 = u.pm * BM + wr * 64 + fr, col0 = u.pn * BM + wc * 64 + 8 * fq;
#pragma unroll
        for (int ai = 0; ai < 2; ++ai)
#pragma unroll
            for (int m = 0; m < 4; ++m) { bf16_t* rowp = O + (size_t)(row0 + ai * HALF + m * 16) * ldc + col0;
#pragma unroll
                for (int bj = 0; bj < 2; ++bj) *(u32x4*)(rowp + bj * 32) = pack8(acc[ai][bj][m][0], acc[ai][bj][m][1]); }
    }
};
struct EpiMkv {
    static constexpr bool PERM = true, AFTER_DRAIN = true, HEADPERM = true, MIDHOOK = false;
    bf16_t* KI; bf16_t* VI; const float* g_kc; float eps;
    __device__ __forceinline__ void fused(f32x4 (&acc)[2][2][4][2], const Unit& u, int wr, int wc, int fr, int fq, PG8_LAS unsigned char* lds, int wid, int lane) const {
        const int head = (u.pn & 1) * 2 + (wc >> 1), sub = wc & 1; const bool isK = u.pn < 2;
        PG8_LAS float* Pq = (PG8_LAS float*)lds;
        if (isK) {
#pragma unroll
            for (int ai = 0; ai < 2; ++ai)
#pragma unroll
                for (int m = 0; m < 4; ++m) { float sq = 0.f;
#pragma unroll
                    for (int bj = 0; bj < 2; ++bj)
#pragma unroll
                        for (int n = 0; n < 2; ++n) { const f32x4 x = acc[ai][bj][m][n]; sq += (x[0] * x[0] + x[1] * x[1]) + (x[2] * x[2] + x[3] * x[3]); }
                    sq += __shfl_xor(sq, 16); sq += __shfl_xor(sq, 32);
                    if (fq == 0) Pq[(ai * HALF + wr * 64 + m * 16 + fr) * 4 + wc] = sq; }
        }
        asm volatile("s_waitcnt lgkmcnt(0)" ::: "memory"); __builtin_amdgcn_s_barrier(); asm volatile("" ::: "memory");
        f32x4 gv[2][2];
#pragma unroll
        for (int bj = 0; bj < 2; ++bj)
#pragma unroll
            for (int n = 0; n < 2; ++n) gv[bj][n] = isK ? *(const f32x4*)(g_kc + sub * 64 + 32 * bj + 8 * fq + 4 * n) : (f32x4){1.f, 1.f, 1.f, 1.f};
#pragma unroll
        for (int ai = 0; ai < 2; ++ai)
#pragma unroll
            for (int m = 0; m < 4; ++m) { const int t = ai * HALF + wr * 64 + m * 16 + fr, tile = t >> 6, r = t & 63;
                float rs = 1.f; if (isK) { const float tot = Pq[t * 4 + wc] + Pq[t * 4 + (wc ^ 1)]; rs = __builtin_amdgcn_rsqf(tot * (1.f / 128.f) + eps); }
                const size_t tb = ((size_t)(u.pm * 4 + head) * 4 + tile) * 8192;
#pragma unroll
                for (int bj = 0; bj < 2; ++bj) { const f32x4 v0 = acc[ai][bj][m][0] * rs * gv[bj][0], v1 = acc[ai][bj][m][1] * rs * gv[bj][1];
                    if (isK) *(u32x4*)(KI + tb + (size_t)(sub * 8 + 4 * bj + fq) * 512 + r * 8) = pack8(v0, v1);
                    else *(u32x4*)(VI + tb + (size_t)(sub * 2 + bj) * 2048 + r * 32 + fq * 8) = pack8(v0, v1); } }
    }
};
struct EpiGate {
    static constexpr bool PERM = true, AFTER_DRAIN = false, HEADPERM = true, MIDHOOK = true;
    const bf16_t* G; bf16_t* Y; int ldc;
    __device__ __forceinline__ void mid(f32x4 (&acc)[2][2][4][2], const Unit& u, int wr, int wc, int fr, int fq, int from) const {
        const int gnum = from; const ptrdiff_t dgate = (from == 2) ? -(ptrdiff_t)(2 * 8 * 8192) : (ptrdiff_t)(8 * 8192);
        const bf16_t* gbase = G + ((size_t)((u.pm * 8 + u.pn) * 3 + gnum) * 8 + (wr * 4 + wc)) * 8192 + (fq * 16 + fr) * 8; asm volatile("" : "+v"(gbase));
#pragma unroll
        for (int ai = 0; ai < 2; ++ai)
#pragma unroll
            for (int m = 0; m < 4; ++m)
#pragma unroll
                for (int bj = 0; bj < 2; ++bj) { const bf16_t* gp = gbase + (ai * 8 + m * 2 + bj) * 512; const u32x4 a = *(const u32x4*)gp, b = *(const u32x4*)(gp + dgate);
                    f32x4 n0 = bf4_lo(a.x, a.y), n1 = bf4_lo(a.z, a.w); const f32x4 d0 = bf4_lo(b.x, b.y), d1 = bf4_lo(b.z, b.w);
#pragma unroll
                    for (int j = 0; j < 4; ++j) { n0[j] *= __builtin_amdgcn_rcpf(d0[j]); n1[j] *= __builtin_amdgcn_rcpf(d1[j]); }
                    acc[ai][bj][m][0] *= n0; acc[ai][bj][m][1] *= n1; }
    }
    __device__ __forceinline__ void operator()(const f32x4 (&acc)[2][2][4][2], const Unit& u, int wr, int wc, int fr, int fq) const {
        const int row0 = u.pm * BM + wr * 64 + fr, col0 = u.pn * BM + wc * 64 + 8 * fq;
        const bf16_t* gbase = G + ((size_t)((u.pm * 8 + u.pn) * 3 + (u.rot + 2) % 3) * 8 + (wr * 4 + wc)) * 8192 + (fq * 16 + fr) * 8;
#pragma unroll
        for (int ai = 0; ai < 2; ++ai)
#pragma unroll
            for (int m = 0; m < 4; ++m) { bf16_t* yp = Y + (size_t)(row0 + ai * HALF + m * 16) * ldc + col0;
#pragma unroll
                for (int bj = 0; bj < 2; ++bj) { const u32x4 a = *(const u32x4*)(gbase + (ai * 8 + m * 2 + bj) * 512);
                    *(u32x4*)(yp + bj * 32) = pack8(acc[ai][bj][m][0] * bf4_lo(a.x, a.y), acc[ai][bj][m][1] * bf4_lo(a.z, a.w)); } }
    }
};
struct EpiOut {
    static constexpr bool PERM = false, AFTER_DRAIN = false, HEADPERM = false, MIDHOOK = false;
    const float* X; float* O; int ldc;
    __device__ __forceinline__ void operator()(const f32x4 (&acc)[2][2][4][2], const Unit& u, int wr, int wc, int fr, int fq) const {
        const int row0 = u.pm * BM + wr * 64 + fr, col0 = u.pn * BM + wc * 32 + 4 * fq;
#pragma unroll
        for (int ai = 0; ai < 2; ++ai)
#pragma unroll
            for (int m = 0; m < 4; ++m) { const size_t off = (size_t)(row0 + ai * HALF + m * 16) * ldc + col0;
#pragma unroll
                for (int bj = 0; bj < 2; ++bj)
#pragma unroll
                    for (int n = 0; n < 2; ++n) { const f32x4 xv = *(const f32x4*)(X + off + bj * HALF + n * 16); *(f32x4*)(O + off + bj * HALF + n * 16) = xv + acc[ai][bj][m][n]; } }
    }
};

template <class Epi, class Sched, bool ALIGN_EPI = false, bool SP2 = false>
__device__ __forceinline__ void gemm_phase(PG8_LAS unsigned char* lds, const Gemm g, const Sched& S, const Epi& E) {
    const int tid = threadIdx.x, wid = __builtin_amdgcn_readfirstlane(tid >> 6), lane = tid & 63, wr = wid >> 2, wc = wid & 3, fr = lane & 15, fq = lane >> 4;
    const int K = g.K, nt = K / BK;
    unsigned voffA[2], voffB[2];
#pragma unroll
    for (int i = 0; i < 2; ++i) { int R, C; stage_rc(tid * 16 + i * 8192, R, C); const int Rb = Epi::HEADPERM ? ((R >> 5) * 64 + perm32(R & 31)) : (Epi::PERM ? ((R & ~31) + perm32(R & 31)) : R);
        voffA[i] = (unsigned)(R * K + C) * 2u; voffB[i] = (unsigned)(Rb * K + C) * 2u; }
    const size_t kstep = (size_t)(BK * 2);
    const size_t hstep = (size_t)HALF * K * 2;
    const size_t tstep = 2 * hstep;
    const size_t hstepB = Epi::HEADPERM ? (size_t)32 * K * 2 : hstep;
    const unsigned ldsw = (unsigned)wid * 1024u;
    const int aoff = lds_byte(wr * 64 + fr, fq * 8), boff = lds_byte(wc * 32 + fr, fq * 8);
#define PG8_SA(b, h) (((b) * 2 + (h)) * HTB)
#define PG8_SB(b, h) ((4 + (b) * 2 + (h)) * HTB)
#define PG8_STAGE(bufoff, gbase, voff) do { _Pragma("unroll") for (int _i = 0; _i < 2; ++_i) \
        __builtin_amdgcn_global_load_lds((const unsigned*)((const char*)(gbase) + (voff)[_i]), (PG8_LAS unsigned*)(lds + (bufoff) + ldsw + _i * 8192), 16, 0, 0); } while (0)
#define PG8_LDA(dst, b, h) do { _Pragma("unroll") for (int m = 0; m < 4; ++m) _Pragma("unroll") for (int k = 0; k < 2; ++k) dst[m][k] = *(const PG8_LAS bf16x8*)(lds + PG8_SA(b, h) + aoff + m * 2048 + k * 1024); } while (0)
#define PG8_LDB(dst, b, h) do { _Pragma("unroll") for (int n = 0; n < 2; ++n) _Pragma("unroll") for (int k = 0; k < 2; ++k) dst[n][k] = *(const PG8_LAS bf16x8*)(lds + PG8_SB(b, h) + boff + n * 2048 + k * 1024); } while (0)
#define PG8_MMA(ai, bj, At, Bt) do { __builtin_amdgcn_s_setprio(1); _Pragma("unroll") for (int m = 0; m < 4; ++m) _Pragma("unroll") for (int n = 0; n < 2; ++n) _Pragma("unroll") for (int k = 0; k < 2; ++k) \
        acc[ai][bj][m][n] = __builtin_amdgcn_mfma_f32_16x16x32_bf16(Bt[n][k], At[m][k], acc[ai][bj][m][n], 0, 0, 0); __builtin_amdgcn_s_setprio(0); } while (0)
#define PG8_WAIT_V(n) asm volatile("s_waitcnt vmcnt(" #n ")" ::: "memory")
#define PG8_WAIT_L(n) asm volatile("s_waitcnt lgkmcnt(" #n ")" ::: "memory")
#define PG8_BAR __builtin_amdgcn_s_barrier()
#define PG8_SCHED __builtin_amdgcn_sched_barrier(0)
    Unit cur, nxt; int ui = 0;
    if (!S.next(0, cur)) return;
    f32x4 acc[2][2][4][2];
#pragma unroll
    for (int a = 0; a < 2; ++a)
#pragma unroll
        for (int b = 0; b < 2; ++b)
#pragma unroll
            for (int m = 0; m < 4; ++m)
#pragma unroll
                for (int n = 0; n < 2; ++n) acc[a][b][m][n] = (f32x4){0.f, 0.f, 0.f, 0.f};
    bf16x8 At[4][2], B0[2][2], B1[2][2];
    int ks = 0, h1 = -1, h2 = -1;
    if constexpr (Epi::MIDHOOK) { cur.rot = P3_ROT ? ((int)blockIdx.x & 7) % 3 : 0; ks = 12 * cur.rot; h1 = (cur.rot == 2) ? 8 : 12; h2 = (cur.rot == 0) ? 24 : 20; }
    auto off = [&](int p) -> ptrdiff_t { if constexpr (Epi::MIDHOOK) return (ptrdiff_t)((p + ks >= nt) ? p - nt : p) * (ptrdiff_t)(BK * 2); else return (ptrdiff_t)p * (ptrdiff_t)(BK * 2); };
    const char* cA = (const char*)g.A + (size_t)cur.pm * tstep + (size_t)ks * (BK * 2); const char* cB = (const char*)g.Bt + (size_t)cur.pn * tstep + (size_t)ks * (BK * 2);
    S.a_ready(cur);
    if constexpr (SP2) {
        PG8_STAGE(PG8_SB(0, 0), cB, voffB); PG8_STAGE(PG8_SB(0, 1), cB + hstepB, voffB); PG8_STAGE(PG8_SA(0, 0), cA, voffA); PG8_STAGE(PG8_SA(0, 1), cA + hstep, voffA);
        if (wr == 1) PG8_BAR;
        PG8_WAIT_V(2); PG8_BAR;
        PG8_STAGE(PG8_SB(1, 0), cB + kstep, voffB); PG8_STAGE(PG8_SA(1, 0), cA + kstep, voffA); PG8_STAGE(PG8_SB(1, 1), cB + hstepB + kstep, voffB);
        PG8_WAIT_V(6); PG8_BAR;
    } else {
        PG8_STAGE(PG8_SB(0, 0), cB, voffB); PG8_STAGE(PG8_SA(0, 0), cA, voffA); PG8_STAGE(PG8_SB(0, 1), cB + hstepB, voffB); PG8_STAGE(PG8_SA(0, 1), cA + hstep, voffA);
        if (wr == 1) PG8_BAR;
        PG8_WAIT_V(4); PG8_BAR;
        PG8_STAGE(PG8_SB(1, 0), cB + kstep, voffB); PG8_STAGE(PG8_SA(1, 0), cA + kstep, voffA); PG8_STAGE(PG8_SB(1, 1), cB + hstepB + kstep, voffB);
        PG8_WAIT_V(6); PG8_BAR;
    }
    for (;;) {
        const bool has_next = S.next(ui + 1, nxt);
        if constexpr (Epi::MIDHOOK) { if (has_next) nxt.rot = cur.rot; }
        const char* nA = has_next ? (const char*)g.A + (size_t)nxt.pm * tstep + (size_t)ks * (BK * 2) : cA; const char* nB = has_next ? (const char*)g.Bt + (size_t)nxt.pn * tstep + (size_t)ks * (BK * 2) : cB;
        for (int t = 0; t < nt; t += 2) {
            if constexpr (Epi::MIDHOOK) { if (t == h1 || t == h2) E.mid(acc, cur, wr, wc, fr, fq, (t == h1) ? cur.rot : (cur.rot + 1) % 3); }
            const bool last = (t == nt - 2);
            const char* a1 = cA + off(t + 1);
            const char* a2 = last ? nA : cA + off(t + 2); const char* b2 = last ? nB : cB + off(t + 2);
            const char* a3 = a2 + kstep; const char* b3 = b2 + kstep;
            if (last && has_next) S.a_ready(nxt);
            if constexpr (SP2) {
            PG8_LDB(B0, 0, 0); PG8_LDB(B1, 0, 1); PG8_SCHED; PG8_LDA(At, 0, 0); PG8_STAGE(PG8_SA(1, 1), a1 + hstep, voffA);
            PG8_WAIT_V(8); PG8_WAIT_L(0); PG8_BAR; PG8_MMA(0, 0, At, B0); PG8_MMA(0, 1, At, B1); PG8_BAR; PG8_SCHED;
            PG8_LDA(At, 0, 1); PG8_STAGE(PG8_SB(0, 0), b2, voffB); PG8_STAGE(PG8_SB(0, 1), b2 + hstepB, voffB); PG8_STAGE(PG8_SA(0, 0), a2, voffA);
            PG8_WAIT_V(8); PG8_WAIT_L(0); PG8_BAR; PG8_MMA(1, 0, At, B0); PG8_MMA(1, 1, At, B1); PG8_BAR; PG8_SCHED;
            PG8_LDB(B0, 1, 0); PG8_LDB(B1, 1, 1); PG8_SCHED; PG8_LDA(At, 1, 0); PG8_STAGE(PG8_SA(0, 1), a2 + hstep, voffA);
            PG8_WAIT_V(8); PG8_WAIT_L(0); PG8_BAR; PG8_MMA(0, 0, At, B0); PG8_MMA(0, 1, At, B1); PG8_BAR; PG8_SCHED;
            PG8_LDA(At, 1, 1); PG8_STAGE(PG8_SB(1, 0), b3, voffB); PG8_STAGE(PG8_SB(1, 1), b3 + hstepB, voffB); PG8_STAGE(PG8_SA(1, 0), a3, voffA);
            PG8_WAIT_V(8); PG8_WAIT_L(0); PG8_BAR; PG8_MMA(1, 0, At, B0); PG8_MMA(1, 1, At, B1); PG8_BAR; PG8_SCHED;
            } else {
            PG8_LDB(B0, 0, 0); PG8_SCHED; PG8_LDA(At, 0, 0); PG8_STAGE(PG8_SA(1, 1), a1 + hstep, voffA);
            PG8_WAIT_L(8); PG8_BAR; PG8_WAIT_L(0); PG8_MMA(0, 0, At, B0); PG8_BAR; PG8_SCHED;
            PG8_LDB(B1, 0, 1); PG8_STAGE(PG8_SB(0, 0), b2, voffB);
            PG8_BAR; PG8_WAIT_L(0); PG8_MMA(0, 1, At, B1); PG8_BAR;
            PG8_LDA(At, 0, 1); PG8_STAGE(PG8_SA(0, 0), a2, voffA);
            PG8_BAR; PG8_WAIT_L(0); PG8_MMA(1, 0, At, B0); PG8_BAR; PG8_SCHED;
            PG8_STAGE(PG8_SB(0, 1), b2 + hstepB, voffB);
            PG8_WAIT_V(6); PG8_BAR; PG8_MMA(1, 1, At, B1); PG8_BAR;
            PG8_LDB(B0, 1, 0); PG8_SCHED; PG8_LDA(At, 1, 0); PG8_STAGE(PG8_SA(0, 1), a2 + hstep, voffA);
            PG8_WAIT_L(8); PG8_BAR; PG8_WAIT_L(0); PG8_MMA(0, 0, At, B0); PG8_BAR; PG8_SCHED;
            PG8_LDB(B1, 1, 1); PG8_STAGE(PG8_SB(1, 0), b3, voffB);
            PG8_BAR; PG8_WAIT_L(0); PG8_MMA(0, 1, At, B1); PG8_BAR;
            PG8_LDA(At, 1, 1); PG8_STAGE(PG8_SA(1, 0), a3, voffA);
            PG8_BAR; PG8_WAIT_L(0); PG8_MMA(1, 0, At, B0); PG8_BAR; PG8_SCHED;
            PG8_STAGE(PG8_SB(1, 1), b3 + hstepB, voffB);
            PG8_WAIT_V(6); PG8_BAR; PG8_MMA(1, 1, At, B1); PG8_BAR;
            }
        }
        if constexpr (ALIGN_EPI) { if (wr == 0) PG8_BAR; }
        if constexpr (!Epi::AFTER_DRAIN) { E(acc, cur, wr, wc, fr, fq); S.done(cur); }
        if (!has_next) break;
#pragma unroll
        for (int a = 0; a < 2; ++a)
#pragma unroll
            for (int b = 0; b < 2; ++b)
#pragma unroll
                for (int m = 0; m < 4; ++m)
#pragma unroll
                    for (int n = 0; n < 2; ++n) acc[a][b][m][n] = (f32x4){0.f, 0.f, 0.f, 0.f};
        cur = nxt; cA = nA; cB = nB; ++ui;
        if constexpr (ALIGN_EPI) { if (wr == 1) PG8_BAR; }
    }
    PG8_WAIT_V(0);
    if constexpr (!ALIGN_EPI) { if (wr == 0) PG8_BAR; }
    PG8_BAR;
    if constexpr (Epi::AFTER_DRAIN) { E.fused(acc, cur, wr, wc, fr, fq, lds, wid, lane); S.done(cur); }
#undef PG8_SA
#undef PG8_SB
#undef PG8_STAGE
#undef PG8_LDA
#undef PG8_LDB
#undef PG8_MMA
#undef PG8_WAIT_V
#undef PG8_WAIT_L
#undef PG8_BAR
#undef PG8_SCHED
}
}
#define GAS __attribute__((address_space(1)))
#define LAS __attribute__((address_space(3)))
typedef unsigned v4u __attribute__((ext_vector_type(4)));
typedef float f32x4 __attribute__((ext_vector_type(4)));
typedef short bf16x8 __attribute__((ext_vector_type(8)));
typedef GAS unsigned gu32;
typedef GAS unsigned long long gu64;
#define RLX_AGENT __ATOMIC_RELAXED, __HIP_MEMORY_SCOPE_AGENT
#define LDS_WAIT() asm volatile("s_waitcnt lgkmcnt(0)" ::: "memory")
#define VM_WAIT() asm volatile("s_waitcnt vmcnt(0)" ::: "memory")
__device__ __forceinline__ unsigned long long rt() { return __builtin_amdgcn_s_memrealtime(); }

#define XB_TMO      128
#define XB_XCNT(j)  (256  + 64 * (j))
#define XB_XSUB(j)  (1280 + 64 * (j))
#define XB_XGEN(j)  (2304 + 64 * (j))
#define XB_TOP      3328
#define XB_TOPGEN   3392
#define XCD_BAR_WORDS 3456
#define XB_SPIN_CAP (1u << 18)

__device__ __forceinline__ unsigned xb_ld(unsigned* p)              { return __hip_atomic_load(p, __ATOMIC_RELAXED, __HIP_MEMORY_SCOPE_AGENT); }
__device__ __forceinline__ unsigned xb_add(unsigned* p, unsigned v) { return __hip_atomic_fetch_add(p, v, __ATOMIC_RELAXED, __HIP_MEMORY_SCOPE_AGENT); }
__device__ __forceinline__ unsigned xb_xcc_id() { return (unsigned)__builtin_amdgcn_s_getreg((3 << 11) | 20) & 0xFu; }
#define XB_SPIN(cond, bar) do { unsigned _sp = 0; while (cond) { __builtin_amdgcn_s_sleep(1); \
    if ((++_sp & 255u) == 0u) { if (xb_ld(&(bar)[XB_TMO])) break; if (_sp > XB_SPIN_CAP) { atomicAdd(&(bar)[XB_TMO], 1u); break; } } } } while (0)

struct XcdBarrier {
    unsigned* bar; unsigned x;
    volatile LAS unsigned* st;
};

__device__ __forceinline__ XcdBarrier xcd_barrier_post(unsigned* bar, volatile LAS unsigned* st) {
    XcdBarrier b; b.bar = bar; b.x = xb_xcc_id(); b.st = st;
    if (threadIdx.x == 0) (void)xb_add(&bar[XB_XCNT(b.x)], 1u);
    return b;
}
__device__ __forceinline__ void xcd_barrier_complete(unsigned* bar, unsigned x, unsigned& nloc, unsigned& nx) {
    const unsigned G = gridDim.x * gridDim.y * gridDim.z;
    unsigned sum, cnt, mine, sp = 0u;
    for (;;) {
        sum = 0u; cnt = 0u; mine = 0u;
#pragma unroll
        for (unsigned j = 0; j < 16; ++j) { const unsigned c = xb_ld(&bar[XB_XCNT(j)]); sum += c; cnt += (c > 0u) ? 1u : 0u; mine = (j == x) ? c : mine; }
        if (sum == G) break;
        __builtin_amdgcn_s_sleep(1);
        if ((++sp & 255u) == 0u) { if (xb_ld(&bar[XB_TMO])) break; if (sp > XB_SPIN_CAP) { atomicAdd(&bar[XB_TMO], 1u); break; } }
    }
    nloc = mine > 0u ? mine : 1u; nx = cnt > 0u ? cnt : 1u;
}

__device__ __forceinline__ void xcd_barrier(const XcdBarrier& b) {
    asm volatile("s_waitcnt vmcnt(0)" ::: "memory");
    __syncthreads();
    if (threadIdx.x == 0) {
        unsigned* bar = b.bar;
        __builtin_amdgcn_s_waitcnt(0);
        unsigned nloc = b.st[0], nx = b.st[1];
        if (nloc == 0u) { xcd_barrier_complete(bar, b.x, nloc, nx); b.st[0] = nloc; b.st[1] = nx; }
        const unsigned old = xb_add(&bar[XB_XSUB(b.x)], 1u);
        const unsigned gen = old / nloc;
        if (old + 1u == (gen + 1u) * nloc) {
            __builtin_amdgcn_fence(__ATOMIC_RELEASE, "agent");
            asm volatile("s_waitcnt vmcnt(0)" ::: "memory");
            const unsigned og = xb_add(&bar[XB_TOP], 1u);
            const unsigned tg = og / nx;
            if (og + 1u == (tg + 1u) * nx) xb_add(&bar[XB_TOPGEN], 1u);
            else XB_SPIN(xb_ld(&bar[XB_TOPGEN]) == tg, bar);
            __builtin_amdgcn_fence(__ATOMIC_ACQUIRE, "agent");
            xb_add(&bar[XB_XGEN(b.x)], 1u);
            asm volatile("s_waitcnt vmcnt(0)" ::: "memory");
        } else {
            XB_SPIN(xb_ld(&bar[XB_XGEN(b.x)]) == gen, bar);
            __builtin_amdgcn_fence(__ATOMIC_ACQUIRE, "agent");
            asm volatile("s_waitcnt vmcnt(0)" ::: "memory");
        }
    }
    __syncthreads();
}

constexpr int NWAVES = 8;
constexpr int CW_TMO = 0, CW_CODE = 1;
constexpr int CW_Q = 64;
constexpr int CW_MKF = 1024;
constexpr int CW_P0MK = 2048;
constexpr int CW_BAR = 4096;
constexpr int RING_OFF = 0, RING_BYTES = 131072;
constexpr int LDSCTL_OFF = 136192, MISC_OFF = LDSCTL_OFF + 320;
constexpr int T0L_OFF = LDSCTL_OFF + 1024;
constexpr int LDS_BYTES = 147456;
static_assert(T0L_OFF + 4736 <= LDS_BYTES && LDSCTL_OFF >= RING_BYTES, "LDS map");


namespace att {
typedef short bf16x8 __attribute__((ext_vector_type(8)));
typedef short s16x4 __attribute__((ext_vector_type(4)));
typedef short v4i16_t __attribute__((ext_vector_type(4)));
typedef float f32x16 __attribute__((ext_vector_type(16)));
typedef float f32x4 __attribute__((ext_vector_type(4)));
typedef unsigned u32x4 __attribute__((ext_vector_type(4)));
#define ALAS __attribute__((address_space(3)))
constexpr int LDS_K = 0, LDS_V = 32768, LDS_C = 65536, LDS_WS = LDS_C + 1024, LDS_OST = LDS_WS + 8 * 256, LDS_BYTES = LDS_OST + 8 * 4096;
constexpr int LDS_Q = LDS_BYTES, LDS_CSQ = LDS_Q + 32768, LDS_END = LDS_CSQ + 2048;
#ifndef EARLY_HEAD
#define EARLY_HEAD 0
#endif
constexpr int N_UNITS = 384 + 128 + 384;
#ifndef LPT_SORT
#define LPT_SORT 0
#endif
constexpr bool B128 = true;
constexpr int C_FIRST = 384 + 192;
__device__ __forceinline__ int crow(int r, int hi) { return (r & 3) + 8 * (r >> 2) + 4 * hi; }
__device__ __forceinline__ unsigned cvtpk(float lo, float hi) { typedef float f2 __attribute__((ext_vector_type(2))); typedef __bf16 b2 __attribute__((ext_vector_type(2))); f2 v = {lo, hi}; b2 b = __builtin_convertvector(v, b2); return __builtin_bit_cast(unsigned, b); }
__device__ __forceinline__ s16x4 vtr(const ALAS unsigned char* p) { return __builtin_bit_cast(s16x4, __builtin_amdgcn_ds_read_tr16_b64_v4i16((ALAS v4i16_t*)p)); }
#define MX3(a, b, c) __builtin_fmaxf(__builtin_fmaxf((a), (b)), (c))
__device__ __forceinline__ float rowmax(const f32x16& p0, const f32x16& p1) {
    float a = MX3(p0[0], p0[1], p1[0]), b = MX3(p0[2], p0[3], p1[1]); a = MX3(a, p1[2], p1[3]);
#pragma unroll
    for (int r = 4; r < 16; r += 4) { a = MX3(a, p0[r], p0[r + 1]); b = MX3(b, p0[r + 2], p0[r + 3]); a = MX3(a, p1[r], p1[r + 1]); b = MX3(b, p1[r + 2], p1[r + 3]); }
    float m = __builtin_fmaxf(a, b); auto rr = __builtin_amdgcn_permlane32_swap(__float_as_uint(m), __float_as_uint(m), false, false);
    return __builtin_fmaxf(__uint_as_float(rr[0]), __uint_as_float(rr[1])); }
__device__ __forceinline__ float pair_sum(float v) { auto rr = __builtin_amdgcn_permlane32_swap(__float_as_uint(v), __float_as_uint(v), false, false); return __uint_as_float(rr[0]) + __uint_as_float(rr[1]); }
__device__ __forceinline__ void glds16(const void* g, unsigned lds_dst) { unsigned keep; asm volatile("s_mov_b32 %0, m0\n\ts_mov_b32 m0, %2\n\ts_nop 0\n\tglobal_load_lds_dwordx4 %1, off\n\ts_mov_b32 m0, %0" : "=&s"(keep) : "v"(g), "s"(lds_dst) : "memory"); }
__device__ __forceinline__ void glds4(const void* g, unsigned lds_dst) { unsigned keep; asm volatile("s_mov_b32 %0, m0\n\ts_mov_b32 m0, %2\n\ts_nop 0\n\tglobal_load_lds_dword %1, off\n\ts_mov_b32 m0, %0" : "=&s"(keep) : "v"(g), "s"(lds_dst) : "memory"); }
#define WAIT_BAR(N) asm volatile("s_waitcnt vmcnt(" #N ") lgkmcnt(0)\n\ts_barrier" ::: "memory")
#define LGKM_BAR() asm volatile("s_waitcnt lgkmcnt(0)\n\ts_barrier" ::: "memory")

#if defined(PROBE_REPEAT) && (PROBE_REPEAT == 7 || PROBE_REPEAT == 8 || PROBE_REPEAT == 11 || PROBE_REPEAT == 12 || PROBE_REPEAT == 13 || PROBE_REPEAT == 14 || (PROBE_REPEAT >= 40 && PROBE_REPEAT < 50))
#define PROBE_MAP(u) (u)
#else
#if defined(PROBE_REPEAT) && PROBE_REPEAT == 67
#define PROBE_MAP(u) (T.pflag ? (u) % 384 : (u))
#else
#define PROBE_MAP(u) (((u) >= att::N_UNITS) ? (u) - 512 : (u))
#endif
#endif
struct Tensors { unsigned char* ws; const float* sinks; const float* g_qc; const float* g_kc; const ALAS int* t0tab; const unsigned* mkf; int pflag; unsigned* qctr; unsigned q_lo;
    __device__ __forceinline__ const unsigned short* PG() const { return (const unsigned short*)(ws + WS_PG); }
    __device__ __forceinline__ const unsigned short* QA() const { return (const unsigned short*)(ws + WS_QA); }
    __device__ __forceinline__ const unsigned short* ZA() const { return (const unsigned short*)(ws + WS_ZA); }
    __device__ __forceinline__ const unsigned short* QB() const { return (const unsigned short*)(ws + WS_QB); }
    __device__ __forceinline__ const unsigned short* ZB() const { return (const unsigned short*)(ws + WS_ZB); }
    __device__ __forceinline__ const unsigned short* KB() const { return (const unsigned short*)(ws + WS_KB); }
    __device__ __forceinline__ const unsigned short* VB() const { return (const unsigned short*)(ws + WS_VB); }
    __device__ __forceinline__ const unsigned short* KA() const { return (const unsigned short*)(ws + WS_KA); }
    __device__ __forceinline__ const unsigned short* VA() const { return (const unsigned short*)(ws + WS_VA); }
    __device__ __forceinline__ const unsigned short* MKV() const { return (const unsigned short*)(ws + WS_MKV); }
    __device__ __forceinline__ const float* CS2() const { return (const float*)(ws + WS_CS2); }
    __device__ __forceinline__ unsigned short* U() const { return (unsigned short*)(ws + WS_U); }
    __device__ __forceinline__ unsigned short* U2() const { return (unsigned short*)(ws + WS_END + 2 * MiB); }
};
struct Desc { int kind, b, h, qb, T0, NT, dummy, s0, early, after; };
struct Geo { const unsigned short* Ksrc; const unsigned short* Vsrc; const float* csrow; int pitch; };

__device__ __forceinline__ Desc decode(int u, const ALAS int* t0tab) {
    Desc d; d.dummy = 0; d.s0 = 0; d.early = 0; d.after = 0;
#if defined(PROBE_REPEAT)
    int forceband = 0; if ((PROBE_REPEAT == 12 || PROBE_REPEAT == 13 || PROBE_REPEAT == 14 || (PROBE_REPEAT >= 40 && PROBE_REPEAT < 50)) && u >= N_UNITS) { u -= N_UNITS; d.dummy = 1; forceband = (PROBE_REPEAT == 12); }
    if (PROBE_REPEAT == 7 && u >= N_UNITS) u = 512 + (u - N_UNITS); if (PROBE_REPEAT == 8 && u >= N_UNITS) u = u - N_UNITS; if (PROBE_REPEAT == 11 && u >= N_UNITS) u = 384 + (u - N_UNITS);
#endif
    if (u < 384) { if (LPT_SORT) u = __builtin_amdgcn_readfirstlane(t0tab[384 + u]);
        const int bh = u % 24; d.kind = 1; d.qb = 15 - u / 24; d.b = bh / 12; d.h = bh % 12; d.T0 = __builtin_amdgcn_readfirstlane(t0tab[bh * 16 + d.qb]);
#if defined(PROBE_REPEAT)
        if (PROBE_REPEAT == 9) d.T0 = 0;
        if (PROBE_REPEAT == 10) { d.T0 -= 8; if (d.T0 < 0) d.T0 = 0; }
        if (forceband) d.T0 = d.qb * 4;
        if (PROBE_REPEAT == 50 || PROBE_REPEAT == 67) { const int fnt = __builtin_amdgcn_readfirstlane(t0tab[1152]); if (fnt > 0) { d.T0 = d.qb * 4 + 4 - fnt; if (d.T0 < 0) d.T0 = 0; } }
#endif
        d.NT = d.qb * 4 + 4 - d.T0; if (B128 && (d.NT & 1)) { d.T0 -= 1; d.NT += 1; } }
    else if (u >= C_FIRST && u < C_FIRST + 128) { const int v = u - C_FIRST, bh = v % 8; d.kind = 2; d.qb = v / 8; d.b = bh / 4; d.h = bh % 4; d.T0 = 0; d.NT = MEMT / 64; }
    else { const int v = (u < C_FIRST) ? u - 384 : u - 512, bh = v % 24; d.kind = 0; d.qb = v / 24; d.b = bh / 12; d.h = bh % 12; d.T0 = d.qb * 4 - 2; if (d.T0 < 0) d.T0 = 0; d.NT = d.qb * 4 + 4 - d.T0; }
    return d;
}
__device__ __forceinline__ Geo geo(const Tensors& T, const Desc& d) {
    Geo g;
    if (d.kind == 0) { const int kvh = d.h / 3; g.Ksrc = T.KA() + (size_t)(d.b * 4 + kvh) * 64 * 4096; g.Vsrc = T.VA() + (size_t)(d.b * 4 + kvh) * 64 * 4096; g.pitch = 0; g.csrow = T.CS2(); }
    else if (d.kind == 1) { g.Ksrc = T.KB() + (size_t)(d.b * 12 + d.h) * 64 * 4096; g.Vsrc = T.VB() + (size_t)(d.b * 12 + d.h) * 64 * 4096; g.pitch = 0; g.csrow = T.CS2() + ((size_t)d.b * 12 + d.h) * SEQ; }
    else { g.Ksrc = T.MKV() + (size_t)(d.b * 4 + d.h) * 4 * 8192; g.Vsrc = g.Ksrc + 262144; g.pitch = 0; g.csrow = T.CS2(); }
    return g;
}
__device__ __forceinline__ void issue_tile(const Geo& g, int kind, int tile, int s, unsigned lds0, int wid, int lane) {
    const size_t kr = (size_t)tile * 64;
    if (kind != 2) {
        const size_t to = (size_t)tile * 4096 + wid * 512 + lane * 8;
        glds16(g.Ksrc + to, (unsigned)__builtin_amdgcn_readfirstlane((int)(lds0 + LDS_K + s * 8192 + wid * 1024)));
        glds16(g.Vsrc + to, (unsigned)__builtin_amdgcn_readfirstlane((int)(lds0 + LDS_V + s * 8192 + wid * 1024)));
        if (kind == 1 && wid == 0) glds4(g.csrow + kr + lane, (unsigned)__builtin_amdgcn_readfirstlane((int)(lds0 + LDS_C + s * 256)));
    } else {
#pragma unroll
        for (int c = 0; c < 2; ++c) { const int p = wid + 8 * c;
            const size_t to = (size_t)tile * 8192 + p * 512 + lane * 8;
            glds16(g.Ksrc + to, (unsigned)__builtin_amdgcn_readfirstlane((int)(lds0 + LDS_K + s * 16384 + p * 1024)));
            glds16(g.Vsrc + to, (unsigned)__builtin_amdgcn_readfirstlane((int)(lds0 + LDS_V + s * 16384 + p * 1024))); }
    }
}
__device__ __forceinline__ void issue_pair(const Geo& g, int kind, int last, int pr, int s, unsigned lds0, int wid, int lane) {
    const int tlo = last - 2 * pr - 1;
#pragma unroll
    for (int img = 0; img < 2; ++img) { const size_t to = (size_t)(tlo + img) * 4096 + wid * 512 + lane * 8;
        glds16(g.Ksrc + to, (unsigned)__builtin_amdgcn_readfirstlane((int)(lds0 + LDS_K + s * 16384 + img * 8192 + wid * 1024)));
        glds16(g.Vsrc + to, (unsigned)__builtin_amdgcn_readfirstlane((int)(lds0 + LDS_V + s * 16384 + img * 8192 + wid * 1024))); }
    if (kind == 1 && wid == 0) { glds4(g.csrow + (size_t)tlo * 64 + lane, (unsigned)__builtin_amdgcn_readfirstlane((int)(lds0 + LDS_C + s * 512)));
                    glds4(g.csrow + (size_t)tlo * 64 + 64 + lane, (unsigned)__builtin_amdgcn_readfirstlane((int)(lds0 + LDS_C + s * 512 + 256))); }
}
__device__ __forceinline__ void issue_head(const Tensors& T, const Geo& g, const Desc& d, unsigned lds0, int wid, int lane) {
    const int last = d.T0 + d.NT - 1;
    if (d.kind != 2) {
        const unsigned short* qb = (d.kind == 0 ? T.QA() : T.QB()) + ((size_t)(d.b * 12 + d.h) * SEQ + d.qb * 256 + wid * 32) * 64;
#pragma unroll
        for (int i = 0; i < 4; ++i) glds16(qb + (i * 8 + (lane >> 3)) * 64 + (((lane & 7) ^ (lane >> 3)) * 8), (unsigned)__builtin_amdgcn_readfirstlane((int)(lds0 + LDS_Q + wid * 4096 + i * 1024)));
        if (d.kind == 1) glds4(T.CS2() + ((size_t)d.b * 12 + d.h) * SEQ + d.qb * 256 + wid * 32 + lane, (unsigned)__builtin_amdgcn_readfirstlane((int)(lds0 + LDS_CSQ + wid * 256)));
        issue_pair(g, d.kind, last, 0, d.s0, lds0, wid, lane);
    } else issue_tile(g, 2, last, d.s0, lds0, wid, lane);
}
__device__ __forceinline__ void issue_rest(const Geo& g, const Desc& d, unsigned lds0, int wid, int lane) {
    if (d.kind != 2 && d.NT > 2) issue_pair(g, d.kind, d.T0 + d.NT - 1, 1, d.s0 ^ 1, lds0, wid, lane);
}

template <int KIND, int ABL = 0> __device__ __forceinline__ void unit(const Tensors& T, const Desc& dsc, ALAS unsigned char* lds, volatile ALAS unsigned* misc, unsigned nidx, int n_total, int& next_u, Desc& nd) {
    constexpr int DH = (KIND == 2) ? 128 : 64, ND = DH / 16, NO = DH / 32;
    constexpr bool RING = (KIND != 2);
    constexpr int SLOT = RING ? 8192 : 16384;
    int tid = threadIdx.x; asm volatile("" : "+v"(tid));
    const int lane = tid & 63, r32 = lane & 31, hi = lane >> 5; const int wid = __builtin_amdgcn_readfirstlane(tid >> 6);
    unsigned qnext = 1u;
    const int b = dsc.b, h = dsc.h, q0 = dsc.qb * 256, T0 = dsc.T0, NT = dsc.NT; const size_t rowbase = (size_t)b * SEQ;
    const int qabs = q0 + wid * 32 + r32;
    const Geo g = geo(T, dsc);
    const int ucol = (KIND == 0) ? h * 64 : (KIND == 1) ? 768 + h * 64 : 1536 + h * 128;
    const int qzp = (KIND == 2) ? PGW : 64;
    const unsigned short* qbase_ = (KIND == 0) ? T.QA() + ((size_t)(b * 12 + h) * SEQ + q0 + wid * 32) * 64 : (KIND == 1) ? T.QB() + ((size_t)(b * 12 + h) * SEQ + q0 + wid * 32) * 64 : T.PG() + (rowbase + q0 + wid * 32) * PGW + PG_QC + h * 128;
    const unsigned short* zrow_ = (KIND == 0) ? T.ZA() + ((size_t)(b * 12 + h) * SEQ + q0 + wid * 32) * 64 : (KIND == 1) ? T.ZB() + ((size_t)(b * 12 + h) * SEQ + q0 + wid * 32) * 64 : T.PG() + (rowbase + q0 + wid * 32) * PGW + PG_ZC + h * 128;
    const unsigned short* qbase = qbase_; const unsigned short* zrow = zrow_;
#if defined(PROBE_REPEAT)
    if (T.pflag && (PROBE_REPEAT == 55 || PROBE_REPEAT == 56 || PROBE_REPEAT == 64)) { qbase = T.QA() + (size_t)(wid * 32) * 64; }
    if (T.pflag && (PROBE_REPEAT == 55 || PROBE_REPEAT == 57 || PROBE_REPEAT == 64)) { zrow = T.ZA() + (size_t)(wid * 32) * 64; }
#endif
    const unsigned lds0 = (unsigned)(size_t)lds;
    auto knorm = [&](int s) {
        const int row = tid >> 3, c0 = (tid & 7) * 2; ALAS unsigned char* kb = lds + LDS_K + s * SLOT + row * 16;
        bf16x8 a = *(const ALAS bf16x8*)(kb + c0 * 1024), c = *(const ALAS bf16x8*)(kb + (c0 + 1) * 1024);
        float fa[8], fc[8]; float ss = 0.f;
#pragma unroll
        for (int j = 0; j < 8; ++j) { fa[j] = __uint_as_float((unsigned)(unsigned short)a[j] << 16); fc[j] = __uint_as_float((unsigned)(unsigned short)c[j] << 16); ss += fa[j] * fa[j] + fc[j] * fc[j]; }
        ss += __builtin_bit_cast(float, __builtin_amdgcn_ds_swizzle(__builtin_bit_cast(int, ss), (1 << 10) | 0x1f)); ss += __builtin_bit_cast(float, __builtin_amdgcn_ds_swizzle(__builtin_bit_cast(int, ss), (2 << 10) | 0x1f));
        ss += __builtin_bit_cast(float, __builtin_amdgcn_ds_swizzle(__builtin_bit_cast(int, ss), (4 << 10) | 0x1f));
        const float rk = __builtin_amdgcn_rsqf(ss * (1.f / 128.f) + EPS);
        const f32x4 g0 = *(const f32x4*)(T.g_kc + c0 * 8), g1 = *(const f32x4*)(T.g_kc + c0 * 8 + 4), g2 = *(const f32x4*)(T.g_kc + c0 * 8 + 8), g3 = *(const f32x4*)(T.g_kc + c0 * 8 + 12);
        u32x4 oa, oc;
        oa.x = cvtpk(fa[0] * rk * g0[0], fa[1] * rk * g0[1]); oa.y = cvtpk(fa[2] * rk * g0[2], fa[3] * rk * g0[3]); oa.z = cvtpk(fa[4] * rk * g1[0], fa[5] * rk * g1[1]); oa.w = cvtpk(fa[6] * rk * g1[2], fa[7] * rk * g1[3]);
        oc.x = cvtpk(fc[0] * rk * g2[0], fc[1] * rk * g2[1]); oc.y = cvtpk(fc[2] * rk * g2[2], fc[3] * rk * g2[3]); oc.z = cvtpk(fc[4] * rk * g3[0], fc[5] * rk * g3[1]); oc.w = cvtpk(fc[6] * rk * g3[2], fc[7] * rk * g3[3]);
        *(ALAS u32x4*)(kb + c0 * 1024) = oa; *(ALAS u32x4*)(kb + (c0 + 1) * 1024) = oc;
    };
    bf16x8 qr[ND]; float csq = 0.f;
    if (KIND != 2) {
        switch (dsc.after) { case 4: asm volatile("s_waitcnt vmcnt(4)" ::: "memory"); break; case 8: asm volatile("s_waitcnt vmcnt(8)" ::: "memory"); break; case 10: asm volatile("s_waitcnt vmcnt(10)" ::: "memory"); break;
                             case 12: asm volatile("s_waitcnt vmcnt(12)" ::: "memory"); break; case 14: asm volatile("s_waitcnt vmcnt(14)" ::: "memory"); break; default: asm volatile("s_waitcnt vmcnt(0)" ::: "memory"); break; }
#pragma unroll
        for (int d0 = 0; d0 < ND; ++d0) qr[d0] = *(const ALAS bf16x8*)(lds + LDS_Q + wid * 4096 + r32 * 128 + (((2 * d0 + hi) ^ (r32 & 7)) * 16));
        if (KIND == 1) csq = *(const ALAS float*)(lds + LDS_CSQ + wid * 256 + r32 * 4);
#pragma unroll
        for (int i = 0; i < 4; ++i) glds16(zrow + i * 512 + lane * 8, (unsigned)__builtin_amdgcn_readfirstlane((int)(lds0 + LDS_OST + wid * 4096 + i * 1024)));
    } else {
        const unsigned short* Qw = qbase + (size_t)r32 * qzp + hi * 8;
#pragma unroll
        for (int d0 = 0; d0 < ND; ++d0) qr[d0] = *(const bf16x8*)(Qw + d0 * 16);
    }
    if (tid == 0) { typedef __attribute__((address_space(1))) unsigned gu32a; gu32a* qp = (gu32a*)T.qctr; asm volatile("" : "+v"(qp));
        qnext = __hip_atomic_fetch_add(qp, 1u, __ATOMIC_RELAXED, __HIP_MEMORY_SCOPE_AGENT); }
    if (KIND == 2) {
        float ss = 0.f;
#pragma unroll
        for (int d0 = 0; d0 < ND; ++d0)
#pragma unroll
            for (int j = 0; j < 8; ++j) { const float f = __uint_as_float((unsigned)(unsigned short)qr[d0][j] << 16); ss += f * f; }
        ss = pair_sum(ss);
        const float rq = C2_128 * __builtin_amdgcn_rsqf(ss * (1.f / 128.f) + EPS);
#pragma unroll
        for (int d0 = 0; d0 < ND; ++d0) { const f32x4 g0 = *(const f32x4*)(T.g_qc + d0 * 16 + hi * 8), g1 = *(const f32x4*)(T.g_qc + d0 * 16 + hi * 8 + 4); u32x4 w;
            float f[8];
#pragma unroll
            for (int j = 0; j < 8; ++j) f[j] = __uint_as_float((unsigned)(unsigned short)qr[d0][j] << 16) * rq;
            w.x = cvtpk(f[0] * g0[0], f[1] * g0[1]); w.y = cvtpk(f[2] * g0[2], f[3] * g0[3]); w.z = cvtpk(f[4] * g1[0], f[5] * g1[1]); w.w = cvtpk(f[6] * g1[2], f[7] * g1[3]);
            qr[d0] = __builtin_bit_cast(bf16x8, w); }
    }
#if defined(THR_TEST)
    constexpr float THR = -1000.f;
#else
    constexpr float THR = 8.f;
#endif
    float slope2 = 0.f, mref = 0.f; bool started = (KIND == 0);
    if (KIND == 0) { slope2 = __builtin_amdgcn_exp2f(-8.f * (float)(h + 1) * (1.f / 12.f)) * LOG2E; mref = ((const ALAS float*)T.t0tab)[1160 + h] * LOG2E; }
    f32x16 o[NO], lacc;
#pragma unroll
    for (int d = 0; d < NO; ++d) o[d] = f32x16{};
    { float l0 = (KIND == 0) ? 1.f : 0.f; asm volatile("" : "+v"(l0));
#pragma unroll
      for (int r = 0; r < 16; ++r) lacc[r] = l0; }
    const bf16x8 ones = (bf16x8){0x3f80, 0x3f80, 0x3f80, 0x3f80, 0x3f80, 0x3f80, 0x3f80, 0x3f80};
    ALAS float* wsf = (ALAS float*)(lds + LDS_WS) + wid * 64;
    const int vbl = ((lane >> 4) & 1) * 32 + (lane & 3) * 8 + (4 * hi + ((lane & 15) >> 2)) * 64;
#pragma unroll
    for (int d0 = 0; d0 < ND; ++d0) asm volatile("" : "+v"(qr[d0]));
    asm volatile("" : "+v"(csq), "+v"(mref), "+v"(slope2));
    if (!RING) { WAIT_BAR(0); }
    const int wq0 = q0 + wid * 32;
    int tlo = T0, thi = T0 + NT - 1;
    if (KIND == 0) { int a = wq0 - 127; a = a < 0 ? 0 : a; tlo = a >> 6; thi = (wq0 + 31) >> 6; }
    if (KIND == 1) { thi = (wq0 + 31) >> 6; }
    u32x4 pw[4];
    auto QKI = [&](f32x16& p0, f32x16& p1, int t) {
        const int tile = T0 + NT - 1 - t, s = RING ? (t & 3) : ((t + dsc.s0) & 1); const ALAS unsigned char* kp = lds + LDS_K + s * SLOT + hi * 1024 + r32 * 16;
            const int kb0 = tile * 64 + 4 * hi;
            if (KIND == 1) { const ALAS f32x4* cs4 = (const ALAS f32x4*)(lds + LDS_C + s * 256); const float cm = csq - mref;
#pragma unroll
                for (int gg = 0; gg < 4; ++gg) { const f32x4 c0 = cs4[2 * gg + hi], c1 = cs4[8 + 2 * gg + hi];
#pragma unroll
                    for (int j = 0; j < 4; ++j) { p0[4 * gg + j] = cm - c0[j]; p1[4 * gg + j] = cm - c1[j]; } } }
            else if (KIND == 0) { const float base = -slope2 * (float)(qabs - kb0) - mref, s32 = 32.f * slope2;
#pragma unroll
                for (int gg = 0; gg < 4; ++gg) { const float bg = __builtin_fmaf(slope2, (float)(8 * gg), base);
#pragma unroll
                    for (int j = 0; j < 4; ++j) { const float v = __builtin_fmaf(slope2, (float)j, bg); p0[4 * gg + j] = v; p1[4 * gg + j] = v + s32; } } }
            else {
#pragma unroll
                for (int r = 0; r < 16; ++r) { p0[r] = -mref; p1[r] = -mref; } }
            __builtin_amdgcn_sched_barrier(0);
    };
    auto QKM = [&](f32x16& p0, f32x16& p1, int t) {
        const int s = RING ? (t & 3) : ((t + dsc.s0) & 1); const ALAS unsigned char* kp = lds + LDS_K + s * SLOT + hi * 1024 + r32 * 16;
#pragma unroll
        for (int hb = 0; hb < ND / 2; ++hb) {
            bf16x8 kf[4];
#pragma unroll
            for (int d0 = 0; d0 < 2; ++d0) { kf[2 * d0] = *(const ALAS bf16x8*)(kp + (2 * hb + d0) * 2048); kf[2 * d0 + 1] = *(const ALAS bf16x8*)(kp + (2 * hb + d0) * 2048 + 512); }
#pragma unroll
            for (int d0 = 0; d0 < 2; ++d0) { p0 = __builtin_amdgcn_mfma_f32_32x32x16_bf16(kf[2 * d0], qr[2 * hb + d0], p0, 0, 0, 0); p1 = __builtin_amdgcn_mfma_f32_32x32x16_bf16(kf[2 * d0 + 1], qr[2 * hb + d0], p1, 0, 0, 0); }
        }
    };
    auto POST = [&](f32x16& p0, f32x16& p1, int t) -> bool {
        const int tile = T0 + NT - 1 - t; const int kb0 = tile * 64 + 4 * hi;
            if (KIND == 1) { if (tile * 64 + 63 > wq0) {
#pragma unroll
                for (int r = 0; r < 16; ++r) { const int kv = kb0 + (r & 3) + 8 * (r >> 2); if (kv > qabs) p0[r] = -INFINITY; if (kv + 32 > qabs) p1[r] = -INFINITY; } } }
            if (KIND == 0) {
#pragma unroll
                for (int r = 0; r < 16; ++r) { const int rel = qabs - (kb0 + (r & 3) + 8 * (r >> 2)); if (rel < 0 || rel >= 128) p0[r] = -INFINITY; if (rel - 32 < 0 || rel - 32 >= 128) p1[r] = -INFINITY; } }
            const float rm = rowmax(p0, p1);
            if (KIND == 1 && started && __all(rm < -40.f)) return true;
            if (!started || __any(rm > THR)) {
                const float dl = started ? __builtin_fmaxf(rm, 0.f) : (rm > -1e30f ? rm : 0.f);
                mref += dl;
#pragma unroll
                for (int r = 0; r < 16; ++r) { p0[r] -= dl; p1[r] -= dl; }
                if (started) {
                    if (hi == 0) wsf[r32] = __builtin_amdgcn_exp2f(-dl);
                    f32x4 a4[4];
#pragma unroll
                    for (int gg = 0; gg < 4; ++gg) a4[gg] = *(const ALAS f32x4*)(wsf + 8 * gg + 4 * hi);
#pragma unroll
                    for (int r = 0; r < 16; ++r) lacc[r] *= a4[r >> 2][r & 3];
#pragma unroll
                    for (int d = 0; d < NO; ++d)
#pragma unroll
                        for (int r = 0; r < 16; ++r) o[d][r] *= a4[r >> 2][r & 3]; }
                started = true; }
        return false;
    };
    auto EXPP = [&](f32x16& p0, f32x16& p1) {
#pragma unroll
            for (int r = 0; r < 16; ++r) { p0[r] = __builtin_amdgcn_exp2f(p0[r]); p1[r] = __builtin_amdgcn_exp2f(p1[r]); }
            pw[0] = (u32x4){cvtpk(p0[0], p0[1]), cvtpk(p0[2], p0[3]), cvtpk(p0[4], p0[5]), cvtpk(p0[6], p0[7])}; pw[1] = (u32x4){cvtpk(p0[8], p0[9]), cvtpk(p0[10], p0[11]), cvtpk(p0[12], p0[13]), cvtpk(p0[14], p0[15])};
            pw[2] = (u32x4){cvtpk(p1[0], p1[1]), cvtpk(p1[2], p1[3]), cvtpk(p1[4], p1[5]), cvtpk(p1[6], p1[7])}; pw[3] = (u32x4){cvtpk(p1[8], p1[9]), cvtpk(p1[10], p1[11]), cvtpk(p1[12], p1[13]), cvtpk(p1[14], p1[15])};
    };
    auto PV = [&](int t) {
        const int s = RING ? (t & 3) : ((t + dsc.s0) & 1);
            const ALAS unsigned char* vp = lds + LDS_V + s * SLOT + vbl;
            s16x4 vlo[8], vhi[8];
            __builtin_amdgcn_sched_barrier(0);
#pragma unroll
            for (int i = 0; i < 4; ++i) { vlo[i] = vtr(vp + (i >> 2) * 4096 + (i & 3) * 1024); vhi[i] = vtr(vp + (i >> 2) * 4096 + (i & 3) * 1024 + 512); }
            __builtin_amdgcn_sched_barrier(0);
            __builtin_amdgcn_sched_barrier(0);
#pragma unroll
            for (int i = 4; i < 8; ++i) { vlo[i] = vtr(vp + (i >> 2) * 4096 + (i & 3) * 1024); vhi[i] = vtr(vp + (i >> 2) * 4096 + (i & 3) * 1024 + 512); }
#pragma unroll
            for (int ks = 0; ks < 4; ++ks) lacc = __builtin_amdgcn_mfma_f32_32x32x16_bf16(__builtin_bit_cast(bf16x8, pw[ks]), ones, lacc, 0, 0, 0);
#pragma unroll
            for (int i = 0; i < 8; ++i) { const bf16x8 vf = (bf16x8){vlo[i][0], vlo[i][1], vlo[i][2], vlo[i][3], vhi[i][0], vhi[i][1], vhi[i][2], vhi[i][3]};
                o[i >> 2] = __builtin_amdgcn_mfma_f32_32x32x16_bf16(__builtin_bit_cast(bf16x8, pw[i & 3]), vf, o[i >> 2], 0, 0, 0); }
            if (NO > 2) {
#pragma unroll
                for (int i = 0; i < 8; ++i) { vlo[i] = vtr(vp + (2 + (i >> 2)) * 4096 + (i & 3) * 1024); vhi[i] = vtr(vp + (2 + (i >> 2)) * 4096 + (i & 3) * 1024 + 512); }
#pragma unroll
                for (int i = 0; i < 8; ++i) { const bf16x8 vf = (bf16x8){vlo[i][0], vlo[i][1], vlo[i][2], vlo[i][3], vhi[i][0], vhi[i][1], vhi[i][2], vhi[i][3]};
                    o[(NO > 2 ? 2 : 0) + (i >> 2)] = __builtin_amdgcn_mfma_f32_32x32x16_bf16(__builtin_bit_cast(bf16x8, pw[i & 3]), vf, o[(NO > 2 ? 2 : 0) + (i >> 2)], 0, 0, 0); } }
    };
    auto BOTH = [&](f32x16& n0, f32x16& n1, f32x16& c0, f32x16& c1, int tn) {
        const ALAS unsigned char* kp = lds + LDS_K + (tn & 3) * SLOT + hi * 1024 + r32 * 16;
        bf16x8 ka = *(const ALAS bf16x8*)(kp), kb = *(const ALAS bf16x8*)(kp + 512);
#pragma unroll
        for (int d0 = 0; d0 < 4; ++d0) {
            n0 = __builtin_amdgcn_mfma_f32_32x32x16_bf16(ka, qr[d0], n0, 0, 0, 0);
            if (d0 < 3) ka = *(const ALAS bf16x8*)(kp + (d0 + 1) * 2048);
#pragma unroll
            for (int r = 4 * d0; r < 4 * d0 + 4; ++r) c0[r] = __builtin_amdgcn_exp2f(c0[r]);
            { const unsigned a = cvtpk(c0[4 * d0], c0[4 * d0 + 1]), b = cvtpk(c0[4 * d0 + 2], c0[4 * d0 + 3]); if (d0 & 1) { pw[d0 >> 1].z = a; pw[d0 >> 1].w = b; } else { pw[d0 >> 1].x = a; pw[d0 >> 1].y = b; } }
            n1 = __builtin_amdgcn_mfma_f32_32x32x16_bf16(kb, qr[d0], n1, 0, 0, 0);
            if (d0 < 3) kb = *(const ALAS bf16x8*)(kp + (d0 + 1) * 2048 + 512);
#pragma unroll
            for (int r = 4 * d0; r < 4 * d0 + 4; ++r) c1[r] = __builtin_amdgcn_exp2f(c1[r]);
            { const unsigned a = cvtpk(c1[4 * d0], c1[4 * d0 + 1]), b = cvtpk(c1[4 * d0 + 2], c1[4 * d0 + 3]); if (d0 & 1) { pw[2 + (d0 >> 1)].z = a; pw[2 + (d0 >> 1)].w = b; } else { pw[2 + (d0 >> 1)].x = a; pw[2 + (d0 >> 1)].y = b; } }
        }
    };
    const int ta = (T0 + NT - 1) - thi, tb = (T0 + NT - 1) - tlo;
    bool pub = false;
    if (B128 && KIND != 2) {
        int NPR = NT / 2; const int last = T0 + NT - 1;
#if defined(PROBE_REPEAT)
        if (T.pflag && (PROBE_REPEAT == 61 || PROBE_REPEAT == 63)) NPR = 0;
#endif
        f32x16 pL0, pL1, pH0, pH1; u32x4 pw[8];
        for (int t = 0; t < NPR; ++t) {
            const int s = (t + dsc.s0) & 1, tl = last - 2 * t - 1;
            const bool lastst = (EARLY_HEAD & 1) && (t == NPR - 1) && (NPR >= 2);
            if (t == 0) LGKM_BAR();
            else if (lastst) { asm volatile("s_waitcnt vmcnt(0)" ::: "memory"); if (tid == 0) misc[24] = qnext + T.q_lo; LGKM_BAR(); }
            else WAIT_BAR(0);
            if (t >= 1 && t + 1 < NPR) issue_pair(g, KIND, last, t + 1, (t + 1 + dsc.s0) & 1, lds0, wid, lane);
            if (lastst) { next_u = __builtin_amdgcn_readfirstlane((int)misc[24]); pub = true;
                if (next_u < n_total) { nd = decode(PROBE_MAP(next_u), T.t0tab); nd.s0 = (t + 1 + dsc.s0) & 1; nd.early = 1; const Geo ng = geo(T, nd); if (!(EARLY_HEAD & 4)) issue_head(T, ng, nd, lds0, wid, lane); } }
            if (tl <= thi && tl + 1 >= tlo) {
                const ALAS unsigned char* kpL = lds + LDS_K + s * 16384 + hi * 1024 + r32 * 16; const ALAS unsigned char* kpH = kpL + 8192;
                const int kbL = tl * 64 + 4 * hi, kbH = kbL + 64;
                if (KIND == 0) { const float base = -slope2 * (float)(qabs - kbL) - mref, s32 = 32.f * slope2, s64 = 64.f * slope2;
#pragma unroll
                    for (int gg = 0; gg < 4; ++gg) { const float bg = __builtin_fmaf(slope2, (float)(8 * gg), base);
#pragma unroll
                        for (int j = 0; j < 4; ++j) { const float v = __builtin_fmaf(slope2, (float)j, bg); pL0[4 * gg + j] = v; pL1[4 * gg + j] = v + s32; pH0[4 * gg + j] = v + s64; pH1[4 * gg + j] = v + s64 + s32; } } }
                else { const ALAS f32x4* cs4 = (const ALAS f32x4*)(lds + LDS_C + s * 512); const float cm = csq - mref;
#pragma unroll
                  for (int gg = 0; gg < 4; ++gg) { const f32x4 a0 = cs4[2 * gg + hi], a1 = cs4[8 + 2 * gg + hi], b0 = cs4[16 + 2 * gg + hi], b1 = cs4[24 + 2 * gg + hi];
#pragma unroll
                      for (int j = 0; j < 4; ++j) { pL0[4 * gg + j] = cm - a0[j]; pL1[4 * gg + j] = cm - a1[j]; pH0[4 * gg + j] = cm - b0[j]; pH1[4 * gg + j] = cm - b1[j]; } } }
                { bf16x8 ka = *(const ALAS bf16x8*)(kpL), kb = *(const ALAS bf16x8*)(kpL + 512), kc = *(const ALAS bf16x8*)(kpH), kd = *(const ALAS bf16x8*)(kpH + 512);
#pragma unroll
                  for (int d0 = 0; d0 < 4; ++d0) {
                      pL0 = __builtin_amdgcn_mfma_f32_32x32x16_bf16(ka, qr[d0], pL0, 0, 0, 0); if (d0 < 3) ka = *(const ALAS bf16x8*)(kpL + (d0 + 1) * 2048);
                      pL1 = __builtin_amdgcn_mfma_f32_32x32x16_bf16(kb, qr[d0], pL1, 0, 0, 0); if (d0 < 3) kb = *(const ALAS bf16x8*)(kpL + (d0 + 1) * 2048 + 512);
                      pH0 = __builtin_amdgcn_mfma_f32_32x32x16_bf16(kc, qr[d0], pH0, 0, 0, 0); if (d0 < 3) kc = *(const ALAS bf16x8*)(kpH + (d0 + 1) * 2048);
                      pH1 = __builtin_amdgcn_mfma_f32_32x32x16_bf16(kd, qr[d0], pH1, 0, 0, 0); if (d0 < 3) kd = *(const ALAS bf16x8*)(kpH + (d0 + 1) * 2048 + 512); } }
                if (KIND == 0) {
#pragma unroll
                    for (int r = 0; r < 16; ++r) { const int rel = qabs - (kbL + (r & 3) + 8 * (r >> 2));
                        if ((unsigned)rel >= 128u) pL0[r] = -INFINITY; if ((unsigned)(rel - 32) >= 128u) pL1[r] = -INFINITY; if ((unsigned)(rel - 64) >= 128u) pH0[r] = -INFINITY; if ((unsigned)(rel - 96) >= 128u) pH1[r] = -INFINITY; } }
                else if ((tl + 1) * 64 + 63 > wq0) {
#pragma unroll
                    for (int r = 0; r < 16; ++r) { const int kv = kbL + (r & 3) + 8 * (r >> 2);
                        if (kv > qabs) pL0[r] = -INFINITY; if (kv + 32 > qabs) pL1[r] = -INFINITY; if (kv + 64 > qabs) pH0[r] = -INFINITY; if (kv + 96 > qabs) pH1[r] = -INFINITY; } }
                (void)kbH;
                const float rm = __builtin_fmaxf(rowmax(pL0, pL1), rowmax(pH0, pH1));
                bool negl = false;
                if (KIND == 1 && started && __all(rm < -40.f)) negl = true;
                if (!negl) {
                if (!started || __any(rm > THR)) {
                    const float dl = started ? __builtin_fmaxf(rm, 0.f) : (rm > -1e30f ? rm : 0.f);
                    mref += dl;
#pragma unroll
                    for (int r = 0; r < 16; ++r) { pL0[r] -= dl; pL1[r] -= dl; pH0[r] -= dl; pH1[r] -= dl; }
                    if (started) {
                        if (hi == 0) wsf[r32] = __builtin_amdgcn_exp2f(-dl);
                        f32x4 a4[4];
#pragma unroll
                        for (int gg = 0; gg < 4; ++gg) a4[gg] = *(const ALAS f32x4*)(wsf + 8 * gg + 4 * hi);
#pragma unroll
                        for (int r = 0; r < 16; ++r) lacc[r] *= a4[r >> 2][r & 3];
#pragma unroll
                        for (int d = 0; d < NO; ++d)
#pragma unroll
                            for (int r = 0; r < 16; ++r) o[d][r] *= a4[r >> 2][r & 3]; }
                    started = true; }
                const ALAS unsigned char* vpL = lds + LDS_V + s * 16384 + vbl; const ALAS unsigned char* vpH = vpL + 8192;
                s16x4 vl[8], vh[8], wl[8], wh[8];
                __builtin_amdgcn_sched_barrier(0);
#pragma unroll
                for (int i = 0; i < 8; ++i) { vl[i] = vtr(vpL + (i >> 2) * 4096 + (i & 3) * 1024); vh[i] = vtr(vpL + (i >> 2) * 4096 + (i & 3) * 1024 + 512); }
                __builtin_amdgcn_sched_barrier(0);
#pragma unroll
                for (int r = 0; r < 16; ++r) { pL0[r] = __builtin_amdgcn_exp2f(pL0[r]); pL1[r] = __builtin_amdgcn_exp2f(pL1[r]); pH0[r] = __builtin_amdgcn_exp2f(pH0[r]); pH1[r] = __builtin_amdgcn_exp2f(pH1[r]); }
                pw[0] = (u32x4){cvtpk(pL0[0], pL0[1]), cvtpk(pL0[2], pL0[3]), cvtpk(pL0[4], pL0[5]), cvtpk(pL0[6], pL0[7])}; pw[1] = (u32x4){cvtpk(pL0[8], pL0[9]), cvtpk(pL0[10], pL0[11]), cvtpk(pL0[12], pL0[13]), cvtpk(pL0[14], pL0[15])};
                pw[2] = (u32x4){cvtpk(pL1[0], pL1[1]), cvtpk(pL1[2], pL1[3]), cvtpk(pL1[4], pL1[5]), cvtpk(pL1[6], pL1[7])}; pw[3] = (u32x4){cvtpk(pL1[8], pL1[9]), cvtpk(pL1[10], pL1[11]), cvtpk(pL1[12], pL1[13]), cvtpk(pL1[14], pL1[15])};
                pw[4] = (u32x4){cvtpk(pH0[0], pH0[1]), cvtpk(pH0[2], pH0[3]), cvtpk(pH0[4], pH0[5]), cvtpk(pH0[6], pH0[7])}; pw[5] = (u32x4){cvtpk(pH0[8], pH0[9]), cvtpk(pH0[10], pH0[11]), cvtpk(pH0[12], pH0[13]), cvtpk(pH0[14], pH0[15])};
                pw[6] = (u32x4){cvtpk(pH1[0], pH1[1]), cvtpk(pH1[2], pH1[3]), cvtpk(pH1[4], pH1[5]), cvtpk(pH1[6], pH1[7])}; pw[7] = (u32x4){cvtpk(pH1[8], pH1[9]), cvtpk(pH1[10], pH1[11]), cvtpk(pH1[12], pH1[13]), cvtpk(pH1[14], pH1[15])};
                __builtin_amdgcn_sched_barrier(0);
#pragma unroll
                for (int i = 0; i < 8; ++i) { wl[i] = vtr(vpH + (i >> 2) * 4096 + (i & 3) * 1024); wh[i] = vtr(vpH + (i >> 2) * 4096 + (i & 3) * 1024 + 512); }
#pragma unroll
                for (int k = 0; k < 8; ++k) lacc = __builtin_amdgcn_mfma_f32_32x32x16_bf16(__builtin_bit_cast(bf16x8, pw[k]), ones, lacc, 0, 0, 0);
#pragma unroll
                for (int i = 0; i < 8; ++i) { const bf16x8 vf = (bf16x8){vl[i][0], vl[i][1], vl[i][2], vl[i][3], vh[i][0], vh[i][1], vh[i][2], vh[i][3]};
                    o[i >> 2] = __builtin_amdgcn_mfma_f32_32x32x16_bf16(__builtin_bit_cast(bf16x8, pw[i & 3]), vf, o[i >> 2], 0, 0, 0); }
#pragma unroll
                for (int i = 0; i < 8; ++i) { const bf16x8 vf = (bf16x8){wl[i][0], wl[i][1], wl[i][2], wl[i][3], wh[i][0], wh[i][1], wh[i][2], wh[i][3]};
                    o[i >> 2] = __builtin_amdgcn_mfma_f32_32x32x16_bf16(__builtin_bit_cast(bf16x8, pw[4 + (i & 3)]), vf, o[i >> 2], 0, 0, 0); }
                }
            }
        }
    } else {
    constexpr bool PIPE = (KIND == 1);
    if (PIPE) {
        f32x16 pA0, pA1, pB0, pB1;
        bool skA = false, skB = false;
        auto STEP = [&](f32x16& c0, f32x16& c1, bool& skc, f32x16& n0, f32x16& n1, bool& skn, int t) {
            { const int li = (t < 0) ? 2 : (t == 0 ? 3 : t + 2); int nbh = (li < NT - 1 ? li : NT - 1) - (t + 1); if (nbh < 0) nbh = 0;
#if defined(PROBE_REPEAT)
              if (PROBE_REPEAT == 14 && dsc.dummy) { LGKM_BAR(); } else
#endif
              if (KIND == 1 && wid == 0) { if (nbh >= 2) WAIT_BAR(6); else if (nbh == 1) WAIT_BAR(3); else WAIT_BAR(0); }
              else { if (nbh >= 2) WAIT_BAR(4); else if (nbh == 1) WAIT_BAR(2); else WAIT_BAR(0); } }
            if (t < 0) { if (3 < NT) issue_tile(g, KIND, T0 + NT - 1 - 3, 3, lds0, wid, lane); }
            else if (t >= 1) { if (t + 3 < NT) issue_tile(g, KIND, T0 + NT - 1 - (t + 3), (t + 3) & 3, lds0, wid, lane); }
            const bool an = (t + 1 >= ta) && (t + 1 <= tb) && (t + 1 < NT), ac = (t >= ta) && (t <= tb) && (t >= 0) && !skc;
            if (ABL == 43) return;
            if (an && ABL != 44) QKI(n0, n1, t + 1);
            if (ABL == 41) { if (ac) EXPP(c0, c1); } else if (ABL == 45) { if (an) QKM(n0, n1, t + 1); } else { if (an && ac) BOTH(n0, n1, c0, c1, t + 1); else if (an) QKM(n0, n1, t + 1); else if (ac) EXPP(c0, c1); }
            if (ac && ABL != 40) PV(t);
            skn = false; if (an && ABL != 42) skn = POST(n0, n1, t + 1);
        };
        STEP(pB0, pB1, skB, pA0, pA1, skA, -1);
        for (int t = 0; t < NT; t += 2) {
            STEP(pA0, pA1, skA, pB0, pB1, skB, t);
            if (t + 1 < NT) STEP(pB0, pB1, skB, pA0, pA1, skA, t + 1);
        }
    } else if (RING) {
        f32x16 p0, p1;
        for (int t = 0; t < NT; ++t) {
            const int rem = NT - 1 - t;
            if (rem >= 2) WAIT_BAR(4); else if (rem == 1) WAIT_BAR(2); else WAIT_BAR(0);
            if (t + 3 < NT) issue_tile(g, KIND, T0 + NT - 1 - (t + 3), (t + 3) & 3, lds0, wid, lane);
            if (t >= ta && t <= tb) { QKI(p0, p1, t); QKM(p0, p1, t); (void)POST(p0, p1, t); EXPP(p0, p1); PV(t); }
        }
    } else {
        f32x16 p0, p1;
        for (int t = 0; t < NT; ++t) {
            if (t + 1 < NT) issue_tile(g, KIND, T0 + NT - 1 - (t + 1), (t + 1 + dsc.s0) & 1, lds0, wid, lane);
            else if (pub && next_u < n_total) { nd = decode(PROBE_MAP(next_u), T.t0tab); nd.s0 = (t + 1 + dsc.s0) & 1; nd.early = 1; const Geo ng = geo(T, nd); issue_head(T, ng, nd, lds0, wid, lane); }
            QKI(p0, p1, t); QKM(p0, p1, t); (void)POST(p0, p1, t); EXPP(p0, p1); PV(t);
            if ((EARLY_HEAD & 2) && t + 2 == NT) { asm volatile("s_waitcnt vmcnt(0)" ::: "memory"); if (tid == 0) misc[24] = qnext + T.q_lo; LGKM_BAR(); next_u = __builtin_amdgcn_readfirstlane((int)misc[24]); pub = true; }
            else if (t + 1 < NT) WAIT_BAR(0);
        }
    }
    }
    (void)nidx;
    if (!pub) { asm volatile("s_waitcnt vmcnt(0)" ::: "memory"); if (tid == 0) misc[24] = qnext + T.q_lo; }
    LGKM_BAR();
    if (!pub) next_u = __builtin_amdgcn_readfirstlane((int)misc[24]);
    if (next_u < n_total) {
        if (!pub) { nd = decode(PROBE_MAP(next_u), T.t0tab); nd.s0 = 0; nd.early = 0; }
        const Geo ng = geo(T, nd);
        if (!pub || (EARLY_HEAD & 4)) issue_head(T, ng, nd, lds0, wid, lane);
        issue_rest(ng, nd, lds0, wid, lane);
#if defined(PROBE_REPEAT) && (PROBE_REPEAT != -1)
        nd.after = 0;
#else
        nd.after = ((nd.kind != 2 && nd.NT > 2) ? 4 + ((nd.kind == 1 && wid == 0) ? 2 : 0) : 0) + ((KIND == 2) ? 8 : 4);
#endif
    }
#if defined(PROBE_REPEAT)
    if (T.pflag && (PROBE_REPEAT == 62 || PROBE_REPEAT == 63)) return;
#endif
    float rli[16];
#pragma unroll
    for (int r = 0; r < 16; ++r) rli[r] = __builtin_amdgcn_rcpf(lacc[r]);
    ALAS unsigned short* stg = (ALAS unsigned short*)(lds + LDS_OST) + wid * 2048;
    unsigned short* urow = (dsc.dummy ? T.U2() : T.U()) + (rowbase + q0 + wid * 32) * DM + ucol;
    u32x4 zq[NO / 2][4];
#pragma unroll
    for (int pass = 0; pass < NO / 2; ++pass)
#pragma unroll
        for (int i = 0; i < 4; ++i) { if (KIND != 2) zq[pass][i] = *(const ALAS u32x4*)(stg + (i * 8 + (lane >> 3)) * 64 + (lane & 7) * 8);
                                      else zq[pass][i] = *(const u32x4*)(zrow + (size_t)(i * 8 + (lane >> 3)) * qzp + pass * 64 + (lane & 7) * 8); }
    if (KIND != 2) asm volatile("s_waitcnt lgkmcnt(0)" ::: "memory");
    __builtin_amdgcn_sched_barrier(0);
#if defined(PROBE_REPEAT)
    if (T.pflag && PROBE_REPEAT == 66) { asm volatile("" :: "v"(zq[0][0]), "v"(zq[0][3]), "v"(rli[0]), "v"(rli[15])); return; }
#endif
#pragma unroll
    for (int pass = 0; pass < NO / 2; ++pass) {
#pragma unroll
        for (int r = 0; r < 16; ++r) { const int orow = crow(r, hi);
#pragma unroll
            for (int d = 0; d < 2; ++d) stg[orow * 64 + d * 32 + r32] = (unsigned short)(cvtpk(o[pass * 2 + d][r] * rli[r], 0.f) & 0xffffu); }
#pragma unroll
        for (int i = 0; i < 4; ++i) { const int row = i * 8 + (lane >> 3), ch = lane & 7;
            const u32x4 ov = *(const ALAS u32x4*)(stg + row * 64 + ch * 8); const u32x4 zv = zq[pass][i];
            u32x4 w;
            w.x = cvtpk(__uint_as_float(ov.x << 16) * __uint_as_float(zv.x << 16), __uint_as_float(ov.x & 0xffff0000u) * __uint_as_float(zv.x & 0xffff0000u));
            w.y = cvtpk(__uint_as_float(ov.y << 16) * __uint_as_float(zv.y << 16), __uint_as_float(ov.y & 0xffff0000u) * __uint_as_float(zv.y & 0xffff0000u));
            w.z = cvtpk(__uint_as_float(ov.z << 16) * __uint_as_float(zv.z << 16), __uint_as_float(ov.z & 0xffff0000u) * __uint_as_float(zv.z & 0xffff0000u));
            w.w = cvtpk(__uint_as_float(ov.w << 16) * __uint_as_float(zv.w << 16), __uint_as_float(ov.w & 0xffff0000u) * __uint_as_float(zv.w & 0xffff0000u));
#if defined(PROBE_REPEAT)
            if (T.pflag && PROBE_REPEAT == 65) { asm volatile("" :: "v"(w)); } else
#endif
            *(u32x4*)(urow + (size_t)row * DM + pass * 64 + ch * 8) = w; }
    }
}
#undef MX3
#undef WAIT_BAR
#undef LGKM_BAR
#undef ALAS
}

#ifndef PROBE_REPEAT
#define PROBE_REPEAT (-1)
#endif
#ifndef STATIC_FIRST
#define STATIC_FIRST 1
#endif
#ifndef PROBE_WIN_LO
#define PROBE_WIN_LO 0
#define PROBE_WIN_HI 0
#endif
#ifndef P1_ALIGN
#define P1_ALIGN true
#endif
#ifndef P1_SP2
#define P1_SP2 true
#endif
#ifndef P1_WGM
#define P1_WGM 8
#endif

struct Frame {
    LAS unsigned char* lds;
    volatile LAS unsigned* MISC;
    gu32* ctl;
    int tid, lane, wave;
    int vcu, G;
};
__device__ __forceinline__ float wave_sum_f(float v) {
    v += __builtin_bit_cast(float, __builtin_amdgcn_update_dpp(0, __builtin_bit_cast(int, v), 0xB1, 0xf, 0xf, false));
    v += __builtin_bit_cast(float, __builtin_amdgcn_update_dpp(0, __builtin_bit_cast(int, v), 0x4E, 0xf, 0xf, false));
    v += __builtin_bit_cast(float, __builtin_amdgcn_update_dpp(0, __builtin_bit_cast(int, v), 0x141, 0xf, 0xf, false));
    v += __builtin_bit_cast(float, __builtin_amdgcn_update_dpp(0, __builtin_bit_cast(int, v), 0x140, 0xf, 0xf, false));
    v += __builtin_bit_cast(float, __builtin_amdgcn_update_dpp(0, __builtin_bit_cast(int, v), 0x142, 0xa, 0xf, false));
    v += __builtin_bit_cast(float, __builtin_amdgcn_update_dpp(0, __builtin_bit_cast(int, v), 0x143, 0xc, 0xf, false));
    v = __builtin_bit_cast(float, __builtin_amdgcn_readlane(__builtin_bit_cast(int, v), 63));
    return v;
}
__device__ __forceinline__ void p0_item_load(f32x4 (&v)[8], const float* Wsrc, int ldw, int lane) {
#pragma unroll
    for (int i = 0; i < 8; ++i) v[i] = *(const GAS f32x4*)(Wsrc + (size_t)(8 * i + (lane >> 3)) * ldw + 4 * (lane & 7));
}
__device__ __forceinline__ void p0_item_finish(const f32x4 (&v)[8], bf16* dst, int ldd, LAS float* scr, int lane) {
#pragma unroll
    for (int i = 0; i < 8; ++i) { LAS float* d = scr + (8 * i + (lane >> 3)) * 33 + 4 * (lane & 7); d[0] = v[i].x; d[1] = v[i].y; d[2] = v[i].z; d[3] = v[i].w; }
    LDS_WAIT(); asm volatile("" ::: "memory");
    const int c = lane & 7;
#pragma unroll
    for (int j = 0; j < 4; ++j) { const int n = (lane >> 3) + 8 * j; const LAS float* s = scr + (8 * c) * 33 + n;
        v4u o; o.x = pk2(s[0 * 33], s[1 * 33]); o.y = pk2(s[2 * 33], s[3 * 33]); o.z = pk2(s[4 * 33], s[5 * 33]); o.w = pk2(s[6 * 33], s[7 * 33]);
        *(GAS v4u*)(dst + (size_t)n * ldd + 8 * c) = o; }
    LDS_WAIT(); asm volatile("" ::: "memory");
}
__device__ __forceinline__ void rms_row_load(f32x4 (&v)[8], const float* xrow, int lane) { const GAS f32x4* xr = (const GAS f32x4*)xrow + lane;
#pragma unroll
    for (int j = 0; j < 8; ++j) v[j] = xr[64 * j]; }
template <bool FB> __device__ __forceinline__ void rms_row(f32x4 (&v)[8], const f32x4 (&gn)[8], bf16* orow, int lane, const LAS f32x4* wfb4, const float* b_forget, float* lf_out  ) {
    float s = 0.f;
#pragma unroll
    for (int j = 0; j < 8; ++j) { s += (v[j].x * v[j].x + v[j].y * v[j].y) + (v[j].z * v[j].z + v[j].w * v[j].w); }
    const float rstd = 1.f / sqrtf(wave_sum_f(s) * (1.f / DM) + EPS);
    GAS unsigned long long* o8 = (GAS unsigned long long*)orow + lane;
#pragma unroll
    for (int j = 0; j < 8; ++j) { v[j] = v[j] * rstd * gn[j]; o8[64 * j] = (unsigned long long)pk2(v[j].x, v[j].y) | ((unsigned long long)pk2(v[j].z, v[j].w) << 32); }
    if constexpr (FB) {
        float mine = 0.f;
#pragma unroll 1
        for (int h = 0; h < 12; ++h) { float a = 0.f;
#pragma unroll
            for (int j = 0; j < 8; ++j) { const f32x4 w = wfb4[h * 512 + 64 * j + lane]; a += (v[j].x * w.x + v[j].y * w.y) + (v[j].z * w.z + v[j].w * w.w); }
            a = wave_sum_f(a); mine = (lane == h) ? a : mine; }
        if (lane < 12) lf_out[(size_t)lane * SEQ] = log_sigmoidf_(mine + b_forget[lane]);
    }
}
struct Args { const float* in[18]; float* out; unsigned char* ws; int ph_lo, ph_hi, li, pad; };

__device__ __forceinline__ void p0_prologue(Frame& F, const Args& args) {
    unsigned char* ws = args.ws;
    const float* x = args.in[0]; const float* mem = args.in[1]; const float* norm_gain = args.in[2]; const float* mem_norm_gain = args.in[3]; const float* w_in = args.in[4]; const float* b_forget = args.in[5];
    const float* w_mem_kv = args.in[13]; const float* w_br_a = args.in[14]; const float* w_br_b = args.in[15]; const float* w_br_c = args.in[16]; const float* w_out = args.in[17];
    bf16* HN = (bf16*)(ws + WS_HN); bf16* MEMN = (bf16*)(ws + WS_MEMN); float* LF = (float*)(ws + WS_LF);
    bf16* W1T = (bf16*)(ws + WS_W1T); bf16* WMKVT = (bf16*)(ws + WS_WMKVT); bf16* WBRT = (bf16*)(ws + WS_WBRT); bf16* WOUTT = (bf16*)(ws + WS_WOUTT);
    const int NPROD = (F.G > 16) ? 8 : 0; gu32* p0c = F.ctl + CW_P0MK;
    if ((int)blockIdx.x < NPROD) {
        if (PROBE_REPEAT >= 71 && PROBE_REPEAT <= 76 && args.pad) return;
        if (F.tid == 0) { unsigned sp = 0; while (__hip_atomic_load((unsigned*)p0c, __ATOMIC_RELAXED, __HIP_MEMORY_SCOPE_AGENT) < (unsigned)(F.G - NPROD)) { __builtin_amdgcn_s_sleep(8); if (++sp > (1u << 22)) break; }
            __builtin_amdgcn_fence(__ATOMIC_ACQUIRE, "agent"); VM_WAIT(); }
        __syncthreads();
        const int u = (int)blockIdx.x; bf16* MKV = (bf16*)(ws + WS_MKV);
        pg8::Gemm g{MEMN, WMKVT, MM, 1024, DM}; pg8::SingleOrder S{u >> 2, u & 3}; pg8::EpiMkv E{MKV, MKV + 262144, args.in[12], EPS};
        pg8::gemm_phase<pg8::EpiMkv, pg8::SingleOrder, false, true>(F.lds + RING_OFF, g, S, E);
        return;
    }
    int rank = F.vcu; { int below = 0; for (int pb = 0; pb < NPROD; ++pb) { const int pv = (F.G % 8 == 0) ? (pb % 8) * (F.G / 8) + pb / 8 : pb; below += (pv < F.vcu) ? 1 : 0; } rank -= below; }
    const int gw = rank * NWAVES + F.wave, NGW = (F.G - NPROD) * NWAVES;
    LAS float* scr = (LAS float*)(F.lds + RING_OFF + F.wave * 16384);
    constexpr int I_W1 = 32 * (NP / 32), I_MKV = 32 * 32, I_BR = 32 * 64, I_OUT = 32 * 64, NITEMS = I_W1 + I_BR + I_OUT;
    { f32x4 gm[8];
#pragma unroll
      for (int j = 0; j < 8; ++j) gm[j] = ((const f32x4*)mem_norm_gain)[F.lane + 64 * j];
      for (int m = gw; m < MM; m += NGW) { f32x4 vm[8]; rms_row_load(vm, mem + (size_t)m * DM, F.lane); rms_row<false>(vm, gm, MEMN + (size_t)m * DM, F.lane, nullptr, nullptr, nullptr); }
      for (int r = gw; r < I_MKV; r += NGW) { const int kb = r / 32, nb = r % 32, k0 = 64 * kb, n0 = 32 * nb; f32x4 vv[8];
          p0_item_load(vv, w_mem_kv + (size_t)k0 * 1024 + n0, 1024, F.lane); p0_item_finish(vv, WMKVT + (size_t)n0 * DM + k0, DM, scr, F.lane); } }
    VM_WAIT(); __syncthreads();
    if (F.tid == 0) { __builtin_amdgcn_fence(__ATOMIC_RELEASE, "agent"); VM_WAIT(); __hip_atomic_fetch_add((unsigned*)p0c, 1u, __ATOMIC_RELAXED, __HIP_MEMORY_SCOPE_AGENT); }
    if (PROBE_REPEAT == 73 && args.pad) return;
    LAS float* wfb = (LAS float*)(F.lds + RING_OFF);
    for (int k = F.tid; k < DM; k += NWAVES * 64) { const float* src = w_in + (size_t)k * IN_W + SRC_FB; const f32x4 a = *(const f32x4*)src, b = *(const f32x4*)(src + 4), c = *(const f32x4*)(src + 8);
        wfb[0 * DM + k] = a.x; wfb[1 * DM + k] = a.y; wfb[2 * DM + k] = a.z; wfb[3 * DM + k] = a.w; wfb[4 * DM + k] = b.x; wfb[5 * DM + k] = b.y; wfb[6 * DM + k] = b.z; wfb[7 * DM + k] = b.w;
        wfb[8 * DM + k] = c.x; wfb[9 * DM + k] = c.y; wfb[10 * DM + k] = c.z; wfb[11 * DM + k] = c.w; }
    __syncthreads();
    if (PROBE_REPEAT == 74 && args.pad) return;
    { f32x4 gn[8];
#pragma unroll
      for (int j = 0; j < 8; ++j) gn[j] = ((const f32x4*)norm_gain)[F.lane + 64 * j];
      { constexpr int NR = M * (PROBE_REPEAT == 0 ? 2 : 1);
        f32x4 va[8], vb[8];
        if (gw < NR) rms_row_load(va, x + (size_t)(gw % M) * DM, F.lane);
        for (int mm = gw; mm < NR; mm += 2 * NGW) {
            const bool h1 = mm + NGW < NR;
            if (h1) rms_row_load(vb, x + (size_t)((mm + NGW) % M) * DM, F.lane);
            { const int m = mm % M, b = m / SEQ, t = m % SEQ; rms_row<true>(va, gn, HN + (size_t)m * DM, F.lane, (const LAS f32x4*)wfb, b_forget, LF + (size_t)b * 12 * SEQ + t); }
            if (!h1) break;
            const bool h2 = mm + 2 * NGW < NR;
            if (h2) rms_row_load(va, x + (size_t)((mm + 2 * NGW) % M) * DM, F.lane);
            { const int m = (mm + NGW) % M, b = m / SEQ, t = m % SEQ; rms_row<true>(vb, gn, HN + (size_t)m * DM, F.lane, (const LAS f32x4*)wfb, b_forget, LF + (size_t)b * 12 * SEQ + t); }
            if (!h2) break;
        } }
    }
    __syncthreads();
    if (PROBE_REPEAT == 75 && args.pad) return;
    auto item_addr = [&](int it, const float*& src, int& ldw, bf16*& dst) {
        int r = it % NITEMS;
        if (r < I_W1) { const int kb = r / (NP / 32), nb = r % (NP / 32), k0 = 64 * kb, n0 = 32 * nb, sn = n0 + (n0 >= SRC_FB ? 12 : 0); src = w_in + (size_t)k0 * IN_W + sn; ldw = IN_W; dst = W1T + (size_t)n0 * DM + k0; return; } r -= I_W1;
        if (r < I_BR) { const int kb = r / 64, nb = r % 64, k0 = 64 * kb, n0 = 32 * nb;
            src = ((kb < 12) ? w_br_a + (size_t)k0 * DM : (kb < 24) ? w_br_b + (size_t)(k0 - 768) * DM : w_br_c + (size_t)(k0 - 1536) * DM) + n0; ldw = DM; dst = WBRT + (size_t)n0 * DM + k0; return; } r -= I_BR;
        { const int kb = r / 64, nb = r % 64, k0 = 64 * kb, n0 = 32 * nb; src = w_out + (size_t)k0 * DM + n0; ldw = DM; dst = WOUTT + (size_t)n0 * DM + k0; }
    };
    constexpr int NIT = NITEMS * (PROBE_REPEAT == 0 ? 2 : 1);
    const int gwi = (gw + NGW - (M % NGW)) % NGW;
    if (gwi < NIT) {
        f32x4 va[8], vb[8]; const float* src; int ldw; bf16* dst; bf16* dstn = nullptr;
        item_addr(gwi, src, ldw, dst); p0_item_load(va, src, ldw, F.lane);
        for (int it = gwi; it < NIT; it += 2 * NGW) {
            const bool h1 = it + NGW < NIT;
            if (h1) { item_addr(it + NGW, src, ldw, dstn); p0_item_load(vb, src, ldw, F.lane); }
            p0_item_finish(va, dst, DM, scr, F.lane);
            if (!h1) break;
            const bool h2 = it + 2 * NGW < NIT;
            if (h2) { item_addr(it + 2 * NGW, src, ldw, dst); p0_item_load(va, src, ldw, F.lane); }
            p0_item_finish(vb, dstn, DM, scr, F.lane);
            if (!h2) break;
        }
    }
}
__device__ __forceinline__ void cumsum_bh(Frame& F, const float* LF, float* CS2, int* T0TAB, int bh, float fox_thr) {
    const float* src = LF + (size_t)bh * SEQ + F.tid * 8; float* dst = CS2 + (size_t)bh * SEQ + F.tid * 8;
    const f32x4 a = *(const f32x4*)src, b = *(const f32x4*)(src + 4);
    float v[8]; v[0] = a.x; v[1] = v[0] + a.y; v[2] = v[1] + a.z; v[3] = v[2] + a.w; v[4] = v[3] + b.x; v[5] = v[4] + b.y; v[6] = v[5] + b.z; v[7] = v[6] + b.w;
    float incl = v[7];
#pragma unroll
    for (int o = 1; o < 64; o <<= 1) { const float t = __shfl_up(incl, o); if (F.lane >= o) incl += t; }
    if (F.lane == 63) F.MISC[16 + F.wave] = __builtin_bit_cast(unsigned, incl);
    __syncthreads();
    float off = incl - v[7];
    for (int w = 0; w < F.wave; ++w) off += __builtin_bit_cast(float, (unsigned)F.MISC[16 + w]);
    f32x4 o0, o1; o0.x = (v[0] + off) * LOG2E; o0.y = (v[1] + off) * LOG2E; o0.z = (v[2] + off) * LOG2E; o0.w = (v[3] + off) * LOG2E;
    o1.x = (v[4] + off) * LOG2E; o1.y = (v[5] + off) * LOG2E; o1.z = (v[6] + off) * LOG2E; o1.w = (v[7] + off) * LOG2E;
    *(f32x4*)dst = o0; *(f32x4*)(dst + 4) = o1;
    LAS float* csl = (LAS float*)(F.lds + RING_OFF);
    *(LAS f32x4*)(csl + F.tid * 8) = o0; *(LAS f32x4*)(csl + F.tid * 8 + 4) = o1;
    __syncthreads();
    if (F.tid < 16) { const int qb = F.tid, nb = 4 * qb; const float cq0 = csl[256 * qb]; int lo = 0, hi = nb;
        while (lo < hi) { const int mid = (lo + hi) >> 1; if (cq0 - csl[64 * mid + 63] >= -fox_thr) hi = mid; else lo = mid + 1; }
        T0TAB[bh * 16 + qb] = lo; }
    __syncthreads();
}

constexpr int N_PHASES = 5;
__global__ void __launch_bounds__(NWAVES * 64, 2) mega_fwd(Args args) {
    extern __shared__ __attribute__((aligned(16))) unsigned char lds[];
    Frame F;
    F.lds = (LAS unsigned char*)lds;
    F.MISC = (volatile LAS unsigned*)(F.lds + MISC_OFF);
    F.tid = threadIdx.x; F.lane = F.tid & 63; F.wave = __builtin_amdgcn_readfirstlane(F.tid >> 6);
    F.G = gridDim.x; { const int bx = blockIdx.x; F.vcu = (F.G % 8 == 0) ? (bx % 8) * (F.G / 8) + bx / 8 : bx; }
    unsigned char* ws = args.ws;
    F.ctl = (gu32*)(ws + WS_CTL);
    for (int u = F.tid; u < (LDS_BYTES - LDSCTL_OFF) / 4; u += NWAVES * 64) ((LAS unsigned*)(F.lds + LDSCTL_OFF))[u] = 0u;
    __syncthreads();
    const int lo = args.ph_lo, hi = args.ph_hi;
    XcdBarrier bar; bar.bar = (unsigned*)(F.ctl + CW_BAR) + args.li * XCD_BAR_WORDS; bar.x = 0; bar.st = nullptr;
    if (hi - lo > 1) bar = xcd_barrier_post((unsigned*)(F.ctl + CW_BAR) + args.li * XCD_BAR_WORDS, F.MISC + 8);
#define IN(k) (lo <= (k) && (k) < hi)
#define BOTH(k) (IN(k) && IN((k) + 1))
#define GRID_BAR() do { xcd_barrier(bar); if (PROBE_REPEAT == 6) { xcd_barrier(bar); xcd_barrier(bar); } } while (0)
    bf16* HN = (bf16*)(ws + WS_HN); bf16* MEMN = (bf16*)(ws + WS_MEMN); bf16* MKV = (bf16*)(ws + WS_MKV); bf16* PG = (bf16*)(ws + WS_PG); bf16* U = (bf16*)(ws + WS_U); bf16* Y = (bf16*)(ws + WS_Y);
    bf16* QA = (bf16*)(ws + WS_QA); bf16* ZA = (bf16*)(ws + WS_ZA); bf16* QB = (bf16*)(ws + WS_QB); bf16* ZB = (bf16*)(ws + WS_ZB); bf16* KB = (bf16*)(ws + WS_KB); bf16* VB = (bf16*)(ws + WS_VB); bf16* KA = (bf16*)(ws + WS_KA); bf16* VA = (bf16*)(ws + WS_VA);
    bf16* W1T = (bf16*)(ws + WS_W1T); bf16* WMKVT = (bf16*)(ws + WS_WMKVT); bf16* WBRT = (bf16*)(ws + WS_WBRT); bf16* WOUTT = (bf16*)(ws + WS_WOUTT);
    float* CS2 = (float*)(ws + WS_CS2); float* LF = (float*)(ws + WS_LF); int* T0TAB = (int*)(ws + WS_T0);

    if (IN(0)) { p0_prologue(F, args); if (BOTH(0)) GRID_BAR(); }

    if (IN(1)) {
        if ((int)blockIdx.x < BATCH * 12) {
            float gq = fabsf(args.in[9][F.lane]), gk = fabsf(args.in[10][F.lane]);
#pragma unroll
            for (int o = 1; o < 64; o <<= 1) { gq = fmaxf(gq, __shfl_xor(gq, o)); gk = fmaxf(gk, __shfl_xor(gk, o)); }
            cumsum_bh(F, LF, CS2, T0TAB, (int)blockIdx.x, 2.f * (64.f * C2_64 * gq * gk * 1.02f) + 40.f); }
        { pg8::Gemm g{HN, W1T, M, NP, DM}; pg8::StaticOrder S; S.init(M, NP, F.G, (int)blockIdx.x); S.rep = (PROBE_REPEAT == 1) ? 2 : 1; S.wgm = P1_WGM;
          pg8::EpiProj E{PG, QA, ZA, QB, ZB, KB, VB, KA, VA, args.in[6], args.in[7], args.in[9], args.in[10], C2_64, EPS, GATE_MIN};
          pg8::gemm_phase<pg8::EpiProj, pg8::StaticOrder, P1_ALIGN, P1_SP2>(F.lds + RING_OFF, g, S, E);
#if PROBE_REPEAT == 21
          { pg8::EpiPlain E2{(bf16*)(ws + WS_END + 2 * MiB), DM};
            pg8::gemm_phase<pg8::EpiPlain, pg8::StaticOrder, P1_ALIGN, P1_SP2>(F.lds + RING_OFF, g, S, E2); }
#endif
        }
        if (BOTH(1)) GRID_BAR();
    }
    if (IN(2)) {
        gu32* mkf = F.ctl + CW_MKF;
        LAS int* t0l = (LAS int*)(F.lds + T0L_OFF);
        for (int i2 = F.tid; i2 < 384; i2 += NWAVES * 64) t0l[i2] = T0TAB[i2];
        if (F.tid < 12) ((LAS float*)t0l)[1160 + F.tid] = args.in[8][F.tid];
#if PROBE_REPEAT == 50 || PROBE_REPEAT == 67
#ifndef PROBE_FORCE_NT
#define PROBE_FORCE_NT 0
#endif
        if (F.tid == 0) t0l[1152] = args.pad ? PROBE_FORCE_NT : 0;
#endif
        __syncthreads();
        if (LPT_SORT) {
            if (F.tid < 384) { const int bh = F.tid % 24, qb = 15 - F.tid / 24; t0l[768 + F.tid] = qb * 4 + 4 - t0l[bh * 16 + qb]; }
            __syncthreads();
            if (F.tid < 384) { const int my = t0l[768 + F.tid]; int rank = 0;
                for (int j = 0; j < 384; j += 4) { typedef int i32x4_ __attribute__((ext_vector_type(4))); const i32x4_ v = *(const LAS i32x4_*)(t0l + 768 + j);
                    rank += (v.x > my || (v.x == my && j < F.tid)) + (v.y > my || (v.y == my && j + 1 < F.tid)) + (v.z > my || (v.z == my && j + 2 < F.tid)) + (v.w > my || (v.w == my && j + 3 < F.tid)); }
                t0l[384 + rank] = F.tid; }
        }
        constexpr int n_total = att::N_UNITS * (PROBE_REPEAT == 2 ? 2 : 1) + (PROBE_REPEAT == 7 ? 384 : 0) + (PROBE_REPEAT == 8 ? 384 : 0) + (PROBE_REPEAT == 11 ? 128 : 0) + ((PROBE_REPEAT == 12 || PROBE_REPEAT == 13 || PROBE_REPEAT == 14 || (PROBE_REPEAT >= 40 && PROBE_REPEAT < 50)) ? 384 : 0);
#if PROBE_REPEAT >= 50 && PROBE_REPEAT < 70
        const unsigned q_lo = (unsigned)args.pad & 0xffffu; const int n_tot_rt = (args.pad >> 16) ? (args.pad >> 16) : n_total;
#define n_total n_tot_rt
#define P2_WINDOW 1
#else
        const unsigned q_lo = STATIC_FIRST ? (unsigned)F.G : 0u;
#endif
        att::Tensors T{ws, args.in[8], args.in[11], args.in[12], (const LAS int*)t0l, (const unsigned*)mkf, args.pad, (unsigned*)(F.ctl + CW_Q), q_lo};
#if defined(P2_WINDOW) || !STATIC_FIRST
        if (F.tid == 0) { const unsigned q = __hip_atomic_fetch_add((unsigned*)(F.ctl + CW_Q), 1u, __ATOMIC_RELAXED, __HIP_MEMORY_SCOPE_AGENT) + q_lo;
            F.MISC[24] = q; }
        __syncthreads();
        int cu = __builtin_amdgcn_readfirstlane((int)F.MISC[24]);
#else
        int cu = (int)blockIdx.x;
#endif
        if (cu < n_total) {
            att::Desc cur = att::decode(PROBE_MAP(cu), T.t0tab);
            { const att::Geo g0 = att::geo(T, cur); att::issue_head(T, g0, cur, (unsigned)(size_t)(F.lds + RING_OFF), F.wave, F.lane); att::issue_rest(g0, cur, (unsigned)(size_t)(F.lds + RING_OFF), F.wave, F.lane); }
            for (;;) {
                const unsigned nidx = 0u;
                int nu; att::Desc nd = cur;
#if PROBE_REPEAT >= 40 && PROBE_REPEAT < 50
                if (cur.kind == 1 && cur.dummy) att::unit<1, PROBE_REPEAT>(T, cur, F.lds + RING_OFF, F.MISC, nidx, n_total, nu, nd); else
#endif
                if (cur.kind == 1) att::unit<1>(T, cur, F.lds + RING_OFF, F.MISC, nidx, n_total, nu, nd);
                else if (cur.kind == 2) att::unit<2>(T, cur, F.lds + RING_OFF, F.MISC, nidx, n_total, nu, nd);
                else att::unit<0>(T, cur, F.lds + RING_OFF, F.MISC, nidx, n_total, nu, nd);
                if (nu >= n_total) break;
                cur = nd;
            }
        }
        VM_WAIT();
#if PROBE_REPEAT >= 50 && PROBE_REPEAT < 70
#undef n_total
#endif
        if (BOTH(2)) GRID_BAR();
    }
    if (IN(3)) {
        pg8::Gemm g{U, WBRT, M, DM, DM}; pg8::StaticOrder S; S.init(M, DM, F.G, (int)blockIdx.x); S.rep = (PROBE_REPEAT == 3) ? 2 : 1;
        pg8::EpiGate E{PG + (size_t)M * PGW, Y, DM};
        pg8::gemm_phase<pg8::EpiGate, pg8::StaticOrder, true, true>(F.lds + RING_OFF, g, S, E);
#if PROBE_REPEAT == 23
        { pg8::EpiPlain E2{(bf16*)(ws + WS_END + 2 * MiB), DM}; pg8::gemm_phase<pg8::EpiPlain, pg8::StaticOrder, true, true>(F.lds + RING_OFF, g, S, E2); }
#endif
        if (BOTH(3)) GRID_BAR();
    }
    if (IN(4)) {
        pg8::Gemm g{Y, WOUTT, M, DM, DM}; pg8::StaticOrder S; S.init(M, DM, F.G, (int)blockIdx.x); S.rep = (PROBE_REPEAT == 4) ? 2 : 1;
        pg8::EpiOut E{args.in[0], args.out, DM};
        pg8::gemm_phase<pg8::EpiOut, pg8::StaticOrder, true, true>(F.lds + RING_OFF, g, S, E);
    }
#undef IN
#undef BOTH
#undef GRID_BAR
}

static int launch_mega(Args a, int lo, int hi, int li, int grid, hipStream_t stream, int pad = 0) {
    a.ph_lo = lo; a.ph_hi = hi; a.li = li; a.pad = pad;
    hipLaunchKernelGGL(mega_fwd, dim3(grid), dim3(NWAVES * 64), LDS_BYTES, stream, a);
    const hipError_t le = hipPeekAtLastError();
    if (le != hipSuccess) { fprintf(stderr, "kernel_launch: launch [%d,%d) failed: %s\n", lo, hi, hipGetErrorName(le)); return -1; }
    return 0;
}
extern "C" void kernel_launch(void* const* d_in, const int* in_sizes, int n_in, void* d_out, int out_size, void* d_ws, size_t ws_size, hipStream_t stream) {
    static int grid = 0;
    if (grid == 0) {
        if (n_in != 18 || in_sizes[0] != M * DM || out_size != M * DM || ws_size < WS_END) { fprintf(stderr, "kernel_launch: unexpected shapes (n_in %d, in0 %d, out %d, ws %zu)\n", n_in, n_in > 0 ? in_sizes[0] : -1, out_size, ws_size); grid = -1; return; }
        int dev = 0, cus = 0, per_cu = 0;
        if (hipGetDevice(&dev) != hipSuccess || hipDeviceGetAttribute(&cus, hipDeviceAttributeMultiprocessorCount, dev) != hipSuccess) { fprintf(stderr, "kernel_launch: device query failed\n"); grid = -1; return; }
        if (hipFuncSetAttribute((const void*)mega_fwd, hipFuncAttributeMaxDynamicSharedMemorySize, LDS_BYTES) != hipSuccess) { fprintf(stderr, "kernel_launch: hipFuncSetAttribute failed\n"); grid = -1; return; }
        if (hipOccupancyMaxActiveBlocksPerMultiprocessor(&per_cu, (const void*)mega_fwd, NWAVES * 64, LDS_BYTES) != hipSuccess || per_cu < 1) { fprintf(stderr, "kernel_launch: occupancy query reports %d workgroups per CU; not launching\n", per_cu); (void)hipGetLastError(); grid = -1; return; }
        grid = cus;
        if (grid < 64) { fprintf(stderr, "kernel_launch: %d compute units: this phase program expects a full MI355X (eight producer workgroups beside the others)\n", grid); grid = -1; return; }
    }
    if (grid < 0) return;
    if (hipMemsetAsync((char*)d_ws + WS_CTL, 0, CTL_ZERO_BYTES, stream) != hipSuccess) { fprintf(stderr, "kernel_launch: memset failed\n"); return; }
    Args a{};
    for (int i = 0; i < 18; ++i) a.in[i] = (const float*)d_in[i];
    a.out = (float*)d_out; a.ws = (unsigned char*)d_ws;
    unsigned char* ws = (unsigned char*)d_ws;
    bf16* MKV = (bf16*)(ws + WS_MKV); bf16* PG = (bf16*)(ws + WS_PG); bf16* U = (bf16*)(ws + WS_U); bf16* Y = (bf16*)(ws + WS_Y);
    bf16* QA = (bf16*)(ws + WS_QA); bf16* ZA = (bf16*)(ws + WS_ZA); bf16* QB = (bf16*)(ws + WS_QB); bf16* ZB = (bf16*)(ws + WS_ZB); bf16* KB = (bf16*)(ws + WS_KB); bf16* VB = (bf16*)(ws + WS_VB); bf16* KA = (bf16*)(ws + WS_KA); bf16* VA = (bf16*)(ws + WS_VA); float* CS2 = (float*)(ws + WS_CS2);
    const float* sinks_a = (const float*)d_in[8]; const float* q_gain_c = (const float*)d_in[11]; const float* k_gain_c = (const float*)d_in[12];
#if PROBE_REPEAT >= 35 && PROBE_REPEAT <= 38
    if (launch_mega(a, 0, PROBE_REPEAT - 34, 0, grid, stream)) return;
    if (hipMemsetAsync((char*)d_ws + WS_CTL, 0, CTL_ZERO_BYTES, stream) != hipSuccess) return;
#endif
    if (launch_mega(a, 0, N_PHASES, 0, grid, stream)) return;
#if PROBE_REPEAT >= 30 && PROBE_REPEAT <= 34
    if (hipMemsetAsync((char*)d_ws + WS_CTL, 0, CTL_ZERO_BYTES, stream) != hipSuccess) return;
    if (launch_mega(a, 0, PROBE_REPEAT - 30, 0, grid, stream)) return;
#endif
#if PROBE_REPEAT >= 50 && PROBE_REPEAT < 70
    if (hipMemsetAsync((char*)d_ws + WS_CTL, 0, CTL_ZERO_BYTES, stream) != hipSuccess) return;
    if (launch_mega(a, 0, 3, 0, grid, stream, PROBE_REPEAT == 50 ? ((PROBE_WIN_HI << 16) | PROBE_WIN_LO) : PROBE_REPEAT == 51 ? (384 << 16) : PROBE_REPEAT == 52 ? ((896 << 16) | 384) : PROBE_REPEAT == 58 ? (256 << 16) : PROBE_REPEAT == 59 ? ((384 << 16) | 256) : PROBE_REPEAT == 67 ? (1024 << 16) : PROBE_REPEAT >= 60 ? ((1408 << 16) | 384) : (PROBE_REPEAT == 53 || (PROBE_REPEAT >= 55 && PROBE_REPEAT < 58)) ? ((576 << 16) | 384) : PROBE_REPEAT == 54 ? ((704 << 16) | 576) : 0)) return;
#endif
#if PROBE_REPEAT >= 71 && PROBE_REPEAT <= 76
    if (hipMemsetAsync((char*)d_ws + WS_CTL, 0, CTL_ZERO_BYTES, stream) != hipSuccess) return;
    if (launch_mega(a, 0, 1, 0, grid, stream, 1)) return;
#endif
#if PROBE_REPEAT == 80
    for (int rep = 0; rep < 4; ++rep) {
        if (hipMemsetAsync((char*)d_ws + WS_CTL, 0, CTL_ZERO_BYTES, stream) != hipSuccess) return;
        if (launch_mega(a, 2, 3, 0, grid, stream, 0)) return; }
#endif
#if PROBE_REPEAT == 20
    if (hipMemsetAsync((char*)d_ws + WS_CTL, 0, CTL_ZERO_BYTES, stream) != hipSuccess) return;
    if (launch_mega(a, 0, N_PHASES, 0, grid, stream)) return;
#endif
}
```

```cpp
#include <hip/hip_runtime.h>
#include <cstdint>
#include <cstdio>

constexpr int BATCH = 2, SEQ = 4096, DM = 2048, M = BATCH * SEQ;
constexpr int MEMT = 256, MM = BATCH * MEMT;
constexpr int IN_W = 12300;
constexpr int NP = 12288;
constexpr int PC_QA = 0, PC_KA = 768, PC_VA = 1024, PC_ZA = 1280, PC_QB = 2048, PC_KB = 2816, PC_VB = 3584, PC_ZB = 4352, PC_QC = 5120, PC_ZC = 5632, PC_G = 6144;
constexpr int PGW = 1024, PG_QC = 0, PG_ZC = 512;
constexpr int SRC_FB = 5120;
constexpr float LOG2E = 1.4426950408889634f;
constexpr float C2_64 = 0.125f * LOG2E;
constexpr float C2_128 = 0.08838834764831845f * LOG2E;
constexpr float EPS = 1e-6f;
constexpr float GATE_MIN = 1e-18f;

constexpr size_t MiB = 1u << 20;
constexpr size_t WS_CTL = 0, CTL_ZERO_BYTES = 1 * MiB, WS_CS2 = 1 * MiB, WS_LF = 1 * MiB + 512 * 1024, WS_MEMN = 2 * MiB, WS_MKV = 4 * MiB, WS_WMKVT = 6 * MiB, WS_WBRT = 10 * MiB, WS_WOUTT = 18 * MiB,
                 WS_HN = 26 * MiB, WS_W1T = 58 * MiB, WS_P = 106 * MiB, WS_END = 298 * MiB;
constexpr size_t WS_WFB = WS_CS2 + 393216;
constexpr size_t WS_T0 = WS_LF + 393216;
constexpr size_t WS_PG = WS_P, WS_QA = WS_P + 112 * MiB, WS_ZA = WS_QA + 12 * MiB, WS_QB = WS_ZA + 12 * MiB, WS_ZB = WS_QB + 12 * MiB, WS_KB = WS_ZB + 12 * MiB, WS_VB = WS_KB + 12 * MiB, WS_KA = WS_VB + 12 * MiB, WS_VA = WS_KA + 4 * MiB;
static_assert(WS_VA + 4 * MiB == WS_END, "ws map");
constexpr size_t WS_Y = WS_HN;
constexpr size_t WS_U = WS_W1T;

typedef unsigned short bf16;
__device__ __forceinline__ unsigned f2bf(float f) { unsigned u = __builtin_bit_cast(unsigned, f); return (u + 0x7fffu + ((u >> 16) & 1u)) >> 16; }
__device__ __forceinline__ float bf2f(unsigned short h) { return __builtin_bit_cast(float, (unsigned)h << 16); }
__device__ __forceinline__ unsigned pk2(float lo, float hi) { typedef float f2_ __attribute__((ext_vector_type(2))); typedef __bf16 b2_ __attribute__((ext_vector_type(2))); f2_ v = {lo, hi}; b2_ b = __builtin_convertvector(v, b2_); return __builtin_bit_cast(unsigned, b); }
__device__ __forceinline__ float wave_sum(float v) {
#pragma unroll
    for (int o = 1; o < 64; o <<= 1) v += __shfl_xor(v, o);
    return v;
}
__device__ __forceinline__ float sigmoidf_(float x) { return 1.f / (1.f + __expf(-x)); }
__device__ __forceinline__ float log_sigmoidf_(float x) { return fminf(x, 0.f) - log1pf(__expf(-fabsf(x))); }
__device__ __forceinline__ float fast_sigmoid(float v) { return __builtin_amdgcn_rcpf(1.f + __builtin_amdgcn_exp2f(-LOG2E * v)); }

#ifndef P3_ROT
#define P3_ROT 0
#endif
namespace pg8 {
#define PG8_LAS __attribute__((address_space(3)))
typedef unsigned short bf16_t;
typedef short bf16x8 __attribute__((ext_vector_type(8)));
typedef float f32x4 __attribute__((ext_vector_type(4)));
typedef unsigned u32x4 __attribute__((ext_vector_type(4)));
constexpr int BM = 256, BK = 64, HALF = 128, HTB = HALF * BK * 2  , STAGE_BYTES = 8 * HTB, NXCD = 8, WGM = 8;

__host__ __device__ __forceinline__ int lds_byte(int r, int c) { const int st = (r >> 4) * 2 + (c >> 5), rr = r & 15, cc = c & 31, ob = rr * 64 + cc * 2; return st * 1024 + (ob ^ (((ob >> 9) & 1) << 5)); }
__host__ __device__ __forceinline__ void stage_rc(int b, int& R, int& C) { const int st = b / 1024, sb = b % 1024, swz = sb ^ (((sb >> 9) & 1) << 5); R = (st >> 1) * 16 + swz / 64; C = (st & 1) * 32 + (swz % 64) / 2; }
__host__ __device__ __forceinline__ int perm32(int rho) { const int n = rho >> 4, i = rho & 15; return 8 * (i >> 2) + 4 * n + (i & 3); }

struct Unit { int pm, pn, rot; };
struct Gemm { const bf16_t* A; const bf16_t* Bt; int M, N, K; };

struct StaticOrder {
    int nM, nN, nwg, G, c, rep, wgm;
    __host__ __device__ void init(int M, int N, int G_, int c_) { nM = M / BM; nN = N / BM; nwg = nM * nN; G = G_; c = c_; rep = 1; wgm = WGM; }
    __host__ __device__ bool next(int i, Unit& u) const {
        const int rounds = (nwg + G - 1) / G; if (i >= rounds * rep) return false; i = i % rounds;
        const long L = (long)i * G + c; if (L >= nwg) return false;
        int wgid = (int)L; { const int q = nwg / NXCD, r = nwg % NXCD, xcd = wgid % NXCD, off = wgid / NXCD; wgid = (xcd < r ? xcd * (q + 1) : r * (q + 1) + (xcd - r) * q) + off; }
        const int nig = wgm * nN, gid = wgid / nig, fm = gid * wgm, gsz = (nM - fm) < wgm ? (nM - fm) : wgm;
        u.pm = fm + ((wgid % nig) % gsz); u.pn = (wgid % nig) / gsz; u.rot = 0; return true;
    }
    __device__ __forceinline__ void a_ready(const Unit&) const {}
    __device__ __forceinline__ void done(const Unit&) const {}
};

struct SingleOrder { int pm, pn;
    __device__ __forceinline__ bool next(int i, Unit& u) const { if (i != 0) return false; u.pm = pm; u.pn = pn; u.rot = 0; return true; }
    __device__ __forceinline__ void a_ready(const Unit&) const {}
    __device__ __forceinline__ void done(const Unit&) const {}
};
__device__ __forceinline__ unsigned cvt_pk_bf16(float lo, float hi) { unsigned r; asm volatile("v_cvt_pk_bf16_f32 %0, %1, %2" : "=v"(r) : "v"(lo), "v"(hi)); return r; }
typedef float f32x2 __attribute__((ext_vector_type(2)));

__device__ __forceinline__ f32x4 bf4_lo(unsigned a, unsigned b) { return (f32x4){__builtin_bit_cast(float, a << 16), __builtin_bit_cast(float, a & 0xffff0000u), __builtin_bit_cast(float, b << 16), __builtin_bit_cast(float, b & 0xffff0000u)}; }
__device__ __forceinline__ u32x4 pack8(const f32x4 v0, const f32x4 v1) { u32x4 w; w.x = cvt_pk_bf16(v0[0], v0[1]); w.y = cvt_pk_bf16(v0[2], v0[3]); w.z = cvt_pk_bf16(v1[0], v1[1]); w.w = cvt_pk_bf16(v1[2], v1[3]); return w; }
__device__ __forceinline__ float sigm(float v) { return __builtin_amdgcn_rcpf(1.f + __builtin_amdgcn_exp2f(-1.4426950408889634f * v)); }

struct EpiProj {
    static constexpr bool PERM = true, AFTER_DRAIN = false, HEADPERM = true, MIDHOOK = false;
    bf16_t* PG; bf16_t* QA; bf16_t* ZA; bf16_t* QB; bf16_t* ZB; bf16_t* KB; bf16_t* VB; bf16_t* KA; bf16_t* VA;
    const float* g_qa; const float* g_ka; const float* g_qb; const float* g_kb; float qscale; float eps; float gate_min;
    static constexpr int G_OFF = 8192 * 1024;
    __device__ __forceinline__ void operator()(const f32x4 (&acc)[2][2][4][2], const Unit& u, int wr, int wc, int fr, int fq) const {
        const int pn = u.pn; int mode = 0; const float* gain = g_qa; float sc = 1.f;
        int lay = 0; bf16_t* dst = PG; int head = 0, nh = 12, pgcol = 0;
        if (pn < 3) { mode = 3; gain = g_qa; sc = qscale; lay = 1; dst = QA; head = pn * 4 + wc; } else if (pn < 4) { mode = 3; gain = g_ka; lay = 2; dst = KA; head = wc; nh = 4; }
        else if (pn < 5) { mode = 0; lay = 3; dst = VA; head = wc; nh = 4; } else if (pn < 8) { mode = 1; lay = 1; dst = ZA; head = (pn - 5) * 4 + wc; }
        else if (pn < 11) { mode = 3; gain = g_qb; sc = qscale; lay = 1; dst = QB; head = (pn - 8) * 4 + wc; } else if (pn < 14) { mode = 3; gain = g_kb; lay = 2; dst = KB; head = (pn - 11) * 4 + wc; }
        else if (pn < 17) { mode = 0; lay = 3; dst = VB; head = (pn - 14) * 4 + wc; } else if (pn < 20) { mode = 1; lay = 1; dst = ZB; head = (pn - 17) * 4 + wc; }
        else if (pn < 22) { mode = 0; pgcol = (pn - 20) * BM; } else if (pn < 24) { mode = 1; pgcol = 512 + (pn - 22) * BM; } else { mode = 2; lay = 4; }
        const int row0 = u.pm * BM + wr * 64 + fr;
        f32x4 gv[2][2];
#pragma unroll
        for (int bj = 0; bj < 2; ++bj)
#pragma unroll
            for (int n = 0; n < 2; ++n) gv[bj][n] = (mode == 3) ? *(const f32x4*)(gain + 32 * bj + 8 * fq + 4 * n) : (f32x4){1.f, 1.f, 1.f, 1.f};
#pragma unroll
        for (int ai = 0; ai < 2; ++ai)
#pragma unroll
            for (int m = 0; m < 4; ++m) { const int row = row0 + ai * HALF + m * 16, b = row >> 12, t = row & 4095;
                size_t o0, o1;
                if (lay == 4) {
                    const int gi = (pn - 24) >> 3, ct = (pn - 24) & 7;
                    o0 = (size_t)G_OFF + ((((size_t)(u.pm * 8 + ct) * 3 + gi) * 8 + (wr * 4 + wc)) * 16 + (ai * 8 + m * 2)) * 512 + (size_t)(fq * 16 + fr) * 8; o1 = o0 + 512; }
                else if (lay == 0) { o0 = (size_t)row * 1024 + pgcol + wc * 64 + 8 * fq; o1 = o0 + 32; }
                else if (lay == 1) { o0 = ((size_t)(b * 12 + head) * 4096 + t) * 64 + 8 * fq; o1 = o0 + 32; }
                else if (lay == 2) { o0 = ((size_t)(b * nh + head) * 64 + (t >> 6)) * 4096 + fq * 512 + (t & 63) * 8; o1 = o0 + 4 * 512; }
                else { o0 = ((size_t)(b * nh + head) * 64 + (t >> 6)) * 4096 + (t & 63) * 32 + fq * 8; o1 = o0 + 2048; }
                float rs = 1.f;
                if (mode == 3) { float s = 0.f;
#pragma unroll
                    for (int bj = 0; bj < 2; ++bj)
#pragma unroll
                        for (int n = 0; n < 2; ++n) { const f32x4 x = acc[ai][bj][m][n]; s += (x[0] * x[0] + x[1] * x[1]) + (x[2] * x[2] + x[3] * x[3]); }
                    s += __shfl_xor(s, 16); s += __shfl_xor(s, 32);
                    rs = sc * __builtin_amdgcn_rsqf(s * (1.f / 64.f) + eps); }
#pragma unroll
                for (int bj = 0; bj < 2; ++bj) { f32x4 v0 = acc[ai][bj][m][0], v1 = acc[ai][bj][m][1];
                    if (mode == 3) { v0 = v0 * rs * gv[bj][0]; v1 = v1 * rs * gv[bj][1]; }
                    else if (mode == 1) {
#pragma unroll
                        for (int j = 0; j < 4; ++j) { v0[j] = v0[j] * sigm(v0[j]); v1[j] = v1[j] * sigm(v1[j]); } }
                    else if (mode == 2) {
#pragma unroll
                        for (int j = 0; j < 4; ++j) { v0[j] = __builtin_fmaxf(sigm(v0[j]), gate_min); v1[j] = __builtin_fmaxf(sigm(v1[j]), gate_min); } }
                    *(u32x4*)(dst + (bj == 0 ? o0 : o1)) = pack8(v0, v1); } }
    }
};
struct EpiPlain {
    static constexpr bool PERM = true, AFTER_DRAIN = false, HEADPERM = true, MIDHOOK = false;
    bf16_t* O; int ldc;
    __device__ __forceinline__ void operator()(const f32x4 (&acc)[2][2][4][2], const Unit& u, int wr, int wc, int fr, int fq) const {
        const int row0 = u.pm * BM + wr * 64 + fr, col0 = u.pn * BM + wc * 64 + 8 * fq;
#pragma unroll
        for (int ai = 0; ai < 2; ++ai)
#pragma unroll
            for (int m = 0; m < 4; ++m) { bf16_t* rowp = O + (size_t)(row0 + ai * HALF + m * 16) * ldc + col0;
#pragma unroll
                for (int bj = 0; bj < 2; ++bj) *(u32x4*)(rowp + bj * 32) = pack8(acc[ai][bj][m][0], acc[ai][bj][m][1]); }
    }
};
struct EpiMkv {
    static constexpr bool PERM = true, AFTER_DRAIN = true, HEADPERM = true, MIDHOOK = false;
    bf16_t* KI; bf16_t* VI; const float* g_kc; float eps;
    __device__ __forceinline__ void fused(f32x4 (&acc)[2][2][4][2], const Unit& u, int wr, int wc, int fr, int fq, PG8_LAS unsigned char* lds, int wid, int lane) const {
        const int head = (u.pn & 1) * 2 + (wc >> 1), sub = wc & 1; const bool isK = u.pn < 2;
        PG8_LAS float* Pq = (PG8_LAS float*)lds;
        if (isK) {
#pragma unroll
            for (int ai = 0; ai < 2; ++ai)
#pragma unroll
                for (int m = 0; m < 4; ++m) { float sq = 0.f;
#pragma unroll
                    for (int bj = 0; bj < 2; ++bj)
#pragma unroll
                        for (int n = 0; n < 2; ++n) { const f32x4 x = acc[ai][bj][m][n]; sq += (x[0] * x[0] + x[1] * x[1]) + (x[2] * x[2] + x[3] * x[3]); }
                    sq += __shfl_xor(sq, 16); sq += __shfl_xor(sq, 32);
                    if (fq == 0) Pq[(ai * HALF + wr * 64 + m * 16 + fr) * 4 + wc] = sq; }
        }
        asm volatile("s_waitcnt lgkmcnt(0)" ::: "memory"); __builtin_amdgcn_s_barrier(); asm volatile("" ::: "memory");
        f32x4 gv[2][2];
#pragma unroll
        for (int bj = 0; bj < 2; ++bj)
#pragma unroll
            for (int n = 0; n < 2; ++n) gv[bj][n] = isK ? *(const f32x4*)(g_kc + sub * 64 + 32 * bj + 8 * fq + 4 * n) : (f32x4){1.f, 1.f, 1.f, 1.f};
#pragma unroll
        for (int ai = 0; ai < 2; ++ai)
#pragma unroll
            for (int m = 0; m < 4; ++m) { const int t = ai * HALF + wr * 64 + m * 16 + fr, tile = t >> 6, r = t & 63;
                float rs = 1.f; if (isK) { const float tot = Pq[t * 4 + wc] + Pq[t * 4 + (wc ^ 1)]; rs = __builtin_amdgcn_rsqf(tot * (1.f / 128.f) + eps); }
                const size_t tb = ((size_t)(u.pm * 4 + head) * 4 + tile) * 8192;
#pragma unroll
                for (int bj = 0; bj < 2; ++bj) { const f32x4 v0 = acc[ai][bj][m][0] * rs * gv[bj][0], v1 = acc[ai][bj][m][1] * rs * gv[bj][1];
                    if (isK) *(u32x4*)(KI + tb + (size_t)(sub * 8 + 4 * bj + fq) * 512 + r * 8) = pack8(v0, v1);
                    else *(u32x4*)(VI + tb + (size_t)(sub * 2 + bj) * 2048 + r * 32 + fq * 8) = pack8(v0, v1); } }
    }
};
struct EpiGate {
    static constexpr bool PERM = true, AFTER_DRAIN = false, HEADPERM = true, MIDHOOK = true;
    const bf16_t* G; bf16_t* Y; int ldc;
    __device__ __forceinline__ void mid(f32x4 (&acc)[2][2][4][2], const Unit& u, int wr, int wc, int fr, int fq, int from) const {
        const int gnum = from; const ptrdiff_t dgate = (from == 2) ? -(ptrdiff_t)(2 * 8 * 8192) : (ptrdiff_t)(8 * 8192);
        const bf16_t* gbase = G + ((size_t)((u.pm * 8 + u.pn) * 3 + gnum) * 8 + (wr * 4 + wc)) * 8192 + (fq * 16 + fr) * 8; asm volatile("" : "+v"(gbase));
#pragma unroll
        for (int ai = 0; ai < 2; ++ai)
#pragma unroll
            for (int m = 0; m < 4; ++m)
#pragma unroll
                for (int bj = 0; bj < 2; ++bj) { const bf16_t* gp = gbase + (ai * 8 + m * 2 + bj) * 512; const u32x4 a = *(const u32x4*)gp, b = *(const u32x4*)(gp + dgate);
                    f32x4 n0 = bf4_lo(a.x, a.y), n1 = bf4_lo(a.z, a.w); const f32x4 d0 = bf4_lo(b.x, b.y), d1 = bf4_lo(b.z, b.w);
#pragma unroll
                    for (int j = 0; j < 4; ++j) { n0[j] *= __builtin_amdgcn_rcpf(d0[j]); n1[j] *= __builtin_amdgcn_rcpf(d1[j]); }
                    acc[ai][bj][m][0] *= n0; acc[ai][bj][m][1] *= n1; }
    }
    __device__ __forceinline__ void operator()(const f32x4 (&acc)[2][2][4][2], const Unit& u, int wr, int wc, int fr, int fq) const {
        const int row0 = u.pm * BM + wr * 64 + fr, col0 = u.pn * BM + wc * 64 + 8 * fq;
        const bf16_t* gbase = G + ((size_t)((u.pm * 8 + u.pn) * 3 + (u.rot + 2) % 3) * 8 + (wr * 4 + wc)) * 8192 + (fq * 16 + fr) * 8;
#pragma unroll
        for (int ai = 0; ai < 2; ++ai)
#pragma unroll
            for (int m = 0; m < 4; ++m) { bf16_t* yp = Y + (size_t)(row0 + ai * HALF + m * 16) * ldc + col0;
#pragma unroll
                for (int bj = 0; bj < 2; ++bj) { const u32x4 a = *(const u32x4*)(gbase + (ai * 8 + m * 2 + bj) * 512);
                    *(u32x4*)(yp + bj * 32) = pack8(acc[ai][bj][m][0] * bf4_lo(a.x, a.y), acc[ai][bj][m][1] * bf4_lo(a.z, a.w)); } }
    }
};
struct EpiOut {
    static constexpr bool PERM = false, AFTER_DRAIN = false, HEADPERM = false, MIDHOOK = false;
    const float* X; float* O; int ldc;
    __device__ __forceinline__ void operator()(const f32x4 (&acc)[2][2][4][2], const Unit& u, int wr, int wc, int fr, int fq) const {
        const int row0 = u.pm * BM + wr * 64 + fr, col0 = u.pn * BM + wc * 32 + 4 * fq;
#pragma unroll
        for (int ai = 0; ai < 2; ++ai)
#pragma unroll
            for (int m = 0; m < 4; ++m) { const size_t off = (size_t)(row0 + ai * HALF + m * 16) * ldc + col0;
#pragma unroll
                for (int bj = 0; bj < 2; ++bj)
#pragma unroll
                    for (int n = 0; n < 2; ++n) { const f32x4 xv = *(const f32x4*)(X + off + bj * HALF + n * 16); *(f32x4*)(O + off + bj * HALF + n * 16) = xv + acc[ai][bj][m][n]; } }
    }
};

template <class Epi, class Sched, bool ALIGN_EPI = false, bool SP2 = false>
__device__ __forceinline__ void gemm_phase(PG8_LAS unsigned char* lds, const Gemm g, const Sched& S, const Epi& E) {
    const int tid = threadIdx.x, wid = __builtin_amdgcn_readfirstlane(tid >> 6), lane = tid & 63, wr = wid >> 2, wc = wid & 3, fr = lane & 15, fq = lane >> 4;
    const int K = g.K, nt = K / BK;
    unsigned voffA[2], voffB[2];
#pragma unroll
    for (int i = 0; i < 2; ++i) { int R, C; stage_rc(tid * 16 + i * 8192, R, C); const int Rb = Epi::HEADPERM ? ((R >> 5) * 64 + perm32(R & 31)) : (Epi::PERM ? ((R & ~31) + perm32(R & 31)) : R);
        voffA[i] = (unsigned)(R * K + C) * 2u; voffB[i] = (unsigned)(Rb * K + C) * 2u; }
    const size_t kstep = (size_t)(BK * 2);
    const size_t hstep = (size_t)HALF * K * 2;
    const size_t tstep = 2 * hstep;
    const size_t hstepB = Epi::HEADPERM ? (size_t)32 * K * 2 : hstep;
    const unsigned ldsw = (unsigned)wid * 1024u;
    const int aoff = lds_byte(wr * 64 + fr, fq * 8), boff = lds_byte(wc * 32 + fr, fq * 8);
#define PG8_SA(b, h) (((b) * 2 + (h)) * HTB)
#define PG8_SB(b, h) ((4 + (b) * 2 + (h)) * HTB)
#define PG8_STAGE(bufoff, gbase, voff) do { _Pragma("unroll") for (int _i = 0; _i < 2; ++_i) \
        __builtin_amdgcn_global_load_lds((const unsigned*)((const char*)(gbase) + (voff)[_i]), (PG8_LAS unsigned*)(lds + (bufoff) + ldsw + _i * 8192), 16, 0, 0); } while (0)
#define PG8_LDA(dst, b, h) do { _Pragma("unroll") for (int m = 0; m < 4; ++m) _Pragma("unroll") for (int k = 0; k < 2; ++k) dst[m][k] = *(const PG8_LAS bf16x8*)(lds + PG8_SA(b, h) + aoff + m * 2048 + k * 1024); } while (0)
#define PG8_LDB(dst, b, h) do { _Pragma("unroll") for (int n = 0; n < 2; ++n) _Pragma("unroll") for (int k = 0; k < 2; ++k) dst[n][k] = *(const PG8_LAS bf16x8*)(lds + PG8_SB(b, h) + boff + n * 2048 + k * 1024); } while (0)
#define PG8_MMA(ai, bj, At, Bt) do { __builtin_amdgcn_s_setprio(1); _Pragma("unroll") for (int m = 0; m < 4; ++m) _Pragma("unroll") for (int n = 0; n < 2; ++n) _Pragma("unroll") for (int k = 0; k < 2; ++k) \
        acc[ai][bj][m][n] = __builtin_amdgcn_mfma_f32_16x16x32_bf16(Bt[n][k], At[m][k], acc[ai][bj][m][n], 0, 0, 0); __builtin_amdgcn_s_setprio(0); } while (0)
#define PG8_WAIT_V(n) asm volatile("s_waitcnt vmcnt(" #n ")" ::: "memory")
#define PG8_WAIT_L(n) asm volatile("s_waitcnt lgkmcnt(" #n ")" ::: "memory")
#define PG8_BAR __builtin_amdgcn_s_barrier()
#define PG8_SCHED __builtin_amdgcn_sched_barrier(0)
    Unit cur, nxt; int ui = 0;
    if (!S.next(0, cur)) return;
    f32x4 acc[2][2][4][2];
#pragma unroll
    for (int a = 0; a < 2; ++a)
#pragma unroll
        for (int b = 0; b < 2; ++b)
#pragma unroll
            for (int m = 0; m < 4; ++m)
#pragma unroll
                for (int n = 0; n < 2; ++n) acc[a][b][m][n] = (f32x4){0.f, 0.f, 0.f, 0.f};
    bf16x8 At[4][2], B0[2][2], B1[2][2];
    int ks = 0, h1 = -1, h2 = -1;
    if constexpr (Epi::MIDHOOK) { cur.rot = P3_ROT ? ((int)blockIdx.x & 7) % 3 : 0; ks = 12 * cur.rot; h1 = (cur.rot == 2) ? 8 : 12; h2 = (cur.rot == 0) ? 24 : 20; }
    auto off = [&](int p) -> ptrdiff_t { if constexpr (Epi::MIDHOOK) return (ptrdiff_t)((p + ks >= nt) ? p - nt : p) * (ptrdiff_t)(BK * 2); else return (ptrdiff_t)p * (ptrdiff_t)(BK * 2); };
    const char* cA = (const char*)g.A + (size_t)cur.pm * tstep + (size_t)ks * (BK * 2); const char* cB = (const char*)g.Bt + (size_t)cur.pn * tstep + (size_t)ks * (BK * 2);
    S.a_ready(cur);
    if constexpr (SP2) {
        PG8_STAGE(PG8_SB(0, 0), cB, voffB); PG8_STAGE(PG8_SB(0, 1), cB + hstepB, voffB); PG8_STAGE(PG8_SA(0, 0), cA, voffA); PG8_STAGE(PG8_SA(0, 1), cA + hstep, voffA);
        if (wr == 1) PG8_BAR;
        PG8_WAIT_V(2); PG8_BAR;
        PG8_STAGE(PG8_SB(1, 0), cB + kstep, voffB); PG8_STAGE(PG8_SA(1, 0), cA + kstep, voffA); PG8_STAGE(PG8_SB(1, 1), cB + hstepB + kstep, voffB);
        PG8_WAIT_V(6); PG8_BAR;
    } else {
        PG8_STAGE(PG8_SB(0, 0), cB, voffB); PG8_STAGE(PG8_SA(0, 0), cA, voffA); PG8_STAGE(PG8_SB(0, 1), cB + hstepB, voffB); PG8_STAGE(PG8_SA(0, 1), cA + hstep, voffA);
        if (wr == 1) PG8_BAR;
        PG8_WAIT_V(4); PG8_BAR;
        PG8_STAGE(PG8_SB(1, 0), cB + kstep, voffB); PG8_STAGE(PG8_SA(1, 0), cA + kstep, voffA); PG8_STAGE(PG8_SB(1, 1), cB + hstepB + kstep, voffB);
        PG8_WAIT_V(6); PG8_BAR;
    }
    for (;;) {
        const bool has_next = S.next(ui + 1, nxt);
        if constexpr (Epi::MIDHOOK) { if (has_next) nxt.rot = cur.rot; }
        const char* nA = has_next ? (const char*)g.A + (size_t)nxt.pm * tstep + (size_t)ks * (BK * 2) : cA; const char* nB = has_next ? (const char*)g.Bt + (size_t)nxt.pn * tstep + (size_t)ks * (BK * 2) : cB;
        for (int t = 0; t < nt; t += 2) {
            if constexpr (Epi::MIDHOOK) { if (t == h1 || t == h2) E.mid(acc, cur, wr, wc, fr, fq, (t == h1) ? cur.rot : (cur.rot + 1) % 3); }
            const bool last = (t == nt - 2);
            const char* a1 = cA + off(t + 1);
            const char* a2 = last ? nA : cA + off(t + 2); const char* b2 = last ? nB : cB + off(t + 2);
            const char* a3 = a2 + kstep; const char* b3 = b2 + kstep;
            if (last && has_next) S.a_ready(nxt);
            if constexpr (SP2) {
            PG8_LDB(B0, 0, 0); PG8_LDB(B1, 0, 1); PG8_SCHED; PG8_LDA(At, 0, 0); PG8_STAGE(PG8_SA(1, 1), a1 + hstep, voffA);
            PG8_WAIT_V(8); PG8_WAIT_L(0); PG8_BAR; PG8_MMA(0, 0, At, B0); PG8_MMA(0, 1, At, B1); PG8_BAR; PG8_SCHED;
            PG8_LDA(At, 0, 1); PG8_STAGE(PG8_SB(0, 0), b2, voffB); PG8_STAGE(PG8_SB(0, 1), b2 + hstepB, voffB); PG8_STAGE(PG8_SA(0, 0), a2, voffA);
            PG8_WAIT_V(8); PG8_WAIT_L(0); PG8_BAR; PG8_MMA(1, 0, At, B0); PG8_MMA(1, 1, At, B1); PG8_BAR; PG8_SCHED;
            PG8_LDB(B0, 1, 0); PG8_LDB(B1, 1, 1); PG8_SCHED; PG8_LDA(At, 1, 0); PG8_STAGE(PG8_SA(0, 1), a2 + hstep, voffA);
            PG8_WAIT_V(8); PG8_WAIT_L(0); PG8_BAR; PG8_MMA(0, 0, At, B0); PG8_MMA(0, 1, At, B1); PG8_BAR; PG8_SCHED;
            PG8_LDA(At, 1, 1); PG8_STAGE(PG8_SB(1, 0), b3, voffB); PG8_STAGE(PG8_SB(1, 1), b3 + hstepB, voffB); PG8_STAGE(PG8_SA(1, 0), a3, voffA);
            PG8_WAIT_V(8); PG8_WAIT_L(0); PG8_BAR; PG8_MMA(1, 0, At, B0); PG8_MMA(1, 1, At, B1); PG8_BAR; PG8_SCHED;
            } else {
            PG8_LDB(B0, 0, 0); PG8_SCHED; PG8_LDA(At, 0, 0); PG8_STAGE(PG8_SA(1, 1), a1 + hstep, voffA);
            PG8_WAIT_L(8); PG8_BAR; PG8_WAIT_L(0); PG8_MMA(0, 0, At, B0); PG8_BAR; PG8_SCHED;
            PG8_LDB(B1, 0, 1); PG8_STAGE(PG8_SB(0, 0), b2, voffB);
            PG8_BAR; PG8_WAIT_L(0); PG8_MMA(0, 1, At, B1); PG8_BAR;
            PG8_LDA(At, 0, 1); PG8_STAGE(PG8_SA(0, 0), a2, voffA);
            PG8_BAR; PG8_WAIT_L(0); PG8_MMA(1, 0, At, B0); PG8_BAR; PG8_SCHED;
            PG8_STAGE(PG8_SB(0, 1), b2 + hstepB, voffB);
            PG8_WAIT_V(6); PG8_BAR; PG8_MMA(1, 1, At, B1); PG8_BAR;
            PG8_LDB(B0, 1, 0); PG8_SCHED; PG8_LDA(At, 1, 0); PG8_STAGE(PG8_SA(0, 1), a2 + hstep, voffA);
            PG8_WAIT_L(8); PG8_BAR; PG8_WAIT_L(0); PG8_MMA(0, 0, At, B0); PG8_BAR; PG8_SCHED;
            PG8_LDB(B1, 1, 1); PG8_STAGE(PG8_SB(1, 0), b3, voffB);
            PG8_BAR; PG8_WAIT_L(0); PG8_MMA(0, 1, At, B1); PG8_BAR;
            PG8_LDA(At, 1, 1); PG8_STAGE(PG8_SA(1, 0), a3, voffA);
            PG8_BAR; PG8_WAIT_L(0); PG8_MMA(1, 0, At, B0); PG8_BAR; PG8_SCHED;
            PG8_STAGE(PG8_SB(1, 1), b3 + hstepB, voffB);
            PG8_WAIT_V(6); PG8_BAR; PG8_MMA(1, 1, At, B1); PG8_BAR;
            }
        }
        if constexpr (ALIGN_EPI) { if (wr == 0) PG8_BAR; }
        if constexpr (!Epi::AFTER_DRAIN) { E(acc, cur, wr, wc, fr, fq); S.done(cur); }
        if (!has_next) break;
#pragma unroll
        for (int a = 0; a < 2; ++a)
#pragma unroll
            for (int b = 0; b < 2; ++b)
#pragma unroll
                for (int m = 0; m < 4; ++m)
#pragma unroll
                    for (int n = 0; n < 2; ++n) acc[a][b][m][n] = (f32x4){0.f, 0.f, 0.f, 0.f};
        cur = nxt; cA = nA; cB = nB; ++ui;
        if constexpr (ALIGN_EPI) { if (wr == 1) PG8_BAR; }
    }
    PG8_WAIT_V(0);
    if constexpr (!ALIGN_EPI) { if (wr == 0) PG8_BAR; }
    PG8_BAR;
    if constexpr (Epi::AFTER_DRAIN) { E.fused(acc, cur, wr, wc, fr, fq, lds, wid, lane); S.done(cur); }
#undef PG8_SA
#undef PG8_SB
#undef PG8_STAGE
#undef PG8_LDA
#undef PG8_LDB
#undef PG8_MMA
#undef PG8_WAIT_V
#undef PG8_WAIT_L
#undef PG8_BAR
#undef PG8_SCHED
}
}
#define GAS __attribute__((address_space(1)))
#define LAS __attribute__((address_space(3)))
typedef unsigned v4u __attribute__((ext_vector_type(4)));
typedef float f32x4 __attribute__((ext_vector_type(4)));
typedef short bf16x8 __attribute__((ext_vector_type(8)));
typedef GAS unsigned gu32;
typedef GAS unsigned long long gu64;
#define RLX_AGENT __ATOMIC_RELAXED, __HIP_MEMORY_SCOPE_AGENT
#define LDS_WAIT() asm volatile("s_waitcnt lgkmcnt(0)" ::: "memory")
#define VM_WAIT() asm volatile("s_waitcnt vmcnt(0)" ::: "memory")
__device__ __forceinline__ unsigned long long rt() { return __builtin_amdgcn_s_memrealtime(); }

#define XB_TMO      128
#define XB_XCNT(j)  (256  + 64 * (j))
#define XB_XSUB(j)  (1280 + 64 * (j))
#define XB_XGEN(j)  (2304 + 64 * (j))
#define XB_TOP      3328
#define XB_TOPGEN   3392
#define XCD_BAR_WORDS 3456
#define XB_SPIN_CAP (1u << 18)

__device__ __forceinline__ unsigned xb_ld(unsigned* p)              { return __hip_atomic_load(p, __ATOMIC_RELAXED, __HIP_MEMORY_SCOPE_AGENT); }
__device__ __forceinline__ unsigned xb_add(unsigned* p, unsigned v) { return __hip_atomic_fetch_add(p, v, __ATOMIC_RELAXED, __HIP_MEMORY_SCOPE_AGENT); }
__device__ __forceinline__ unsigned xb_xcc_id() { return (unsigned)__builtin_amdgcn_s_getreg((3 << 11) | 20) & 0xFu; }
#define XB_SPIN(cond, bar) do { unsigned _sp = 0; while (cond) { __builtin_amdgcn_s_sleep(1); \
    if ((++_sp & 255u) == 0u) { if (xb_ld(&(bar)[XB_TMO])) break; if (_sp > XB_SPIN_CAP) { atomicAdd(&(bar)[XB_TMO], 1u); break; } } } } while (0)

struct XcdBarrier {
    unsigned* bar; unsigned x;
    volatile LAS unsigned* st;
};

__device__ __forceinline__ XcdBarrier xcd_barrier_post(unsigned* bar, volatile LAS unsigned* st) {
    XcdBarrier b; b.bar = bar; b.x = xb_xcc_id(); b.st = st;
    if (threadIdx.x == 0) (void)xb_add(&bar[XB_XCNT(b.x)], 1u);
    return b;
}
__device__ __forceinline__ void xcd_barrier_complete(unsigned* bar, unsigned x, unsigned& nloc, unsigned& nx) {
    const unsigned G = gridDim.x * gridDim.y * gridDim.z;
    unsigned sum, cnt, mine, sp = 0u;
    for (;;) {
        sum = 0u; cnt = 0u; mine = 0u;
#pragma unroll
        for (unsigned j = 0; j < 16; ++j) { const unsigned c = xb_ld(&bar[XB_XCNT(j)]); sum += c; cnt += (c > 0u) ? 1u : 0u; mine = (j == x) ? c : mine; }
        if (sum == G) break;
        __builtin_amdgcn_s_sleep(1);
        if ((++sp & 255u) == 0u) { if (xb_ld(&bar[XB_TMO])) break; if (sp > XB_SPIN_CAP) { atomicAdd(&bar[XB_TMO], 1u); break; } }
    }
    nloc = mine > 0u ? mine : 1u; nx = cnt > 0u ? cnt : 1u;
}

__device__ __forceinline__ void xcd_barrier(const XcdBarrier& b) {
    asm volatile("s_waitcnt vmcnt(0)" ::: "memory");
    __syncthreads();
    if (threadIdx.x == 0) {
        unsigned* bar = b.bar;
        __builtin_amdgcn_s_waitcnt(0);
        unsigned nloc = b.st[0], nx = b.st[1];
        if (nloc == 0u) { xcd_barrier_complete(bar, b.x, nloc, nx); b.st[0] = nloc; b.st[1] = nx; }
        const unsigned old = xb_add(&bar[XB_XSUB(b.x)], 1u);
        const unsigned gen = old / nloc;
        if (old + 1u == (gen + 1u) * nloc) {
            __builtin_amdgcn_fence(__ATOMIC_RELEASE, "agent");
            asm volatile("s_waitcnt vmcnt(0)" ::: "memory");
            const unsigned og = xb_add(&bar[XB_TOP], 1u);
            const unsigned tg = og / nx;
            if (og + 1u == (tg + 1u) * nx) xb_add(&bar[XB_TOPGEN], 1u);
            else XB_SPIN(xb_ld(&bar[XB_TOPGEN]) == tg, bar);
            __builtin_amdgcn_fence(__ATOMIC_ACQUIRE, "agent");
            xb_add(&bar[XB_XGEN(b.x)], 1u);
            asm volatile("s_waitcnt vmcnt(0)" ::: "memory");
        } else {
            XB_SPIN(xb_ld(&bar[XB_XGEN(b.x)]) == gen, bar);
            __builtin_amdgcn_fence(__ATOMIC_ACQUIRE, "agent");
            asm volatile("s_waitcnt vmcnt(0)" ::: "memory");
        }
    }
    __syncthreads();
}

constexpr int NWAVES = 8;
constexpr int CW_TMO = 0, CW_CODE = 1;
constexpr int CW_Q = 64;
constexpr int CW_MKF = 1024;
constexpr int CW_P0MK = 2048;
constexpr int CW_BAR = 4096;
constexpr int RING_OFF = 0, RING_BYTES = 131072;
constexpr int LDSCTL_OFF = 136192, MISC_OFF = LDSCTL_OFF + 320;
constexpr int T0L_OFF = LDSCTL_OFF + 1024;
constexpr int LDS_BYTES = 147456;
static_assert(T0L_OFF + 4736 <= LDS_BYTES && LDSCTL_OFF >= RING_BYTES, "LDS map");


namespace att {
typedef short bf16x8 __attribute__((ext_vector_type(8)));
typedef short s16x4 __attribute__((ext_vector_type(4)));
typedef short v4i16_t __attribute__((ext_vector_type(4)));
typedef float f32x16 __attribute__((ext_vector_type(16)));
typedef float f32x4 __attribute__((ext_vector_type(4)));
typedef unsigned u32x4 __attribute__((ext_vector_type(4)));
#define ALAS __attribute__((address_space(3)))
constexpr int LDS_K = 0, LDS_V = 32768, LDS_C = 65536, LDS_WS = LDS_C + 1024, LDS_OST = LDS_WS + 8 * 256, LDS_BYTES = LDS_OST + 8 * 4096;
constexpr int LDS_Q = LDS_BYTES, LDS_CSQ = LDS_Q + 32768, LDS_END = LDS_CSQ + 2048;
#ifndef EARLY_HEAD
#define EARLY_HEAD 0
#endif
constexpr int N_UNITS = 384 + 128 + 384;
#ifndef LPT_SORT
#define LPT_SORT 0
#endif
constexpr bool B128 = true;
constexpr int C_FIRST = 384 + 192;
__device__ __forceinline__ int crow(int r, int hi) { return (r & 3) + 8 * (r >> 2) + 4 * hi; }
__device__ __forceinline__ unsigned cvtpk(float lo, float hi) { typedef float f2 __attribute__((ext_vector_type(2))); typedef __bf16 b2 __attribute__((ext_vector_type(2))); f2 v = {lo, hi}; b2 b = __builtin_convertvector(v, b2); return __builtin_bit_cast(unsigned, b); }
__device__ __forceinline__ s16x4 vtr(const ALAS unsigned char* p) { return __builtin_bit_cast(s16x4, __builtin_amdgcn_ds_read_tr16_b64_v4i16((ALAS v4i16_t*)p)); }
#define MX3(a, b, c) __builtin_fmaxf(__builtin_fmaxf((a), (b)), (c))
__device__ __forceinline__ float rowmax(const f32x16& p0, const f32x16& p1) {
    float a = MX3(p0[0], p0[1], p1[0]), b = MX3(p0[2], p0[3], p1[1]); a = MX3(a, p1[2], p1[3]);
#pragma unroll
    for (int r = 4; r < 16; r += 4) { a = MX3(a, p0[r], p0[r + 1]); b = MX3(b, p0[r + 2], p0[r + 3]); a = MX3(a, p1[r], p1[r + 1]); b = MX3(b, p1[r + 2], p1[r + 3]); }
    float m = __builtin_fmaxf(a, b); auto rr = __builtin_amdgcn_permlane32_swap(__float_as_uint(m), __float_as_uint(m), false, false);
    return __builtin_fmaxf(__uint_as_float(rr[0]), __uint_as_float(rr[1])); }
__device__ __forceinline__ float pair_sum(float v) { auto rr = __builtin_amdgcn_permlane32_swap(__float_as_uint(v), __float_as_uint(v), false, false); return __uint_as_float(rr[0]) + __uint_as_float(rr[1]); }
__device__ __forceinline__ void glds16(const void* g, unsigned lds_dst) { unsigned keep; asm volatile("s_mov_b32 %0, m0\n\ts_mov_b32 m0, %2\n\ts_nop 0\n\tglobal_load_lds_dwordx4 %1, off\n\ts_mov_b32 m0, %0" : "=&s"(keep) : "v"(g), "s"(lds_dst) : "memory"); }
__device__ __forceinline__ void glds4(const void* g, unsigned lds_dst) { unsigned keep; asm volatile("s_mov_b32 %0, m0\n\ts_mov_b32 m0, %2\n\ts_nop 0\n\tglobal_load_lds_dword %1, off\n\ts_mov_b32 m0, %0" : "=&s"(keep) : "v"(g), "s"(lds_dst) : "memory"); }
#define WAIT_BAR(N) asm volatile("s_waitcnt vmcnt(" #N ") lgkmcnt(0)\n\ts_barrier" ::: "memory")
#define LGKM_BAR() asm volatile("s_waitcnt lgkmcnt(0)\n\ts_barrier" ::: "memory")

#if defined(PROBE_REPEAT) && (PROBE_REPEAT == 7 || PROBE_REPEAT == 8 || PROBE_REPEAT == 11 || PROBE_REPEAT == 12 || PROBE_REPEAT == 13 || PROBE_REPEAT == 14 || (PROBE_REPEAT >= 40 && PROBE_REPEAT < 50))
#define PROBE_MAP(u) (u)
#else
#if defined(PROBE_REPEAT) && PROBE_REPEAT == 67
#define PROBE_MAP(u) (T.pflag ? (u) % 384 : (u))
#else
#define PROBE_MAP(u) (((u) >= att::N_UNITS) ? (u) - 512 : (u))
#endif
#endif
struct Tensors { unsigned char* ws; const float* sinks; const float* g_qc; const float* g_kc; const ALAS int* t0tab; const unsigned* mkf; int pflag; unsigned* qctr; unsigned q_lo;
    __device__ __forceinline__ const unsigned short* PG() const { return (const unsigned short*)(ws + WS_PG); }
    __device__ __forceinline__ const unsigned short* QA() const { return (const unsigned short*)(ws + WS_QA); }
    __device__ __forceinline__ const unsigned short* ZA() const { return (const unsigned short*)(ws + WS_ZA); }
    __device__ __forceinline__ const unsigned short* QB() const { return (const unsigned short*)(ws + WS_QB); }
    __device__ __forceinline__ const unsigned short* ZB() const { return (const unsigned short*)(ws + WS_ZB); }
    __device__ __forceinline__ const unsigned short* KB() const { return (const unsigned short*)(ws + WS_KB); }
    __device__ __forceinline__ const unsigned short* VB() const { return (const unsigned short*)(ws + WS_VB); }
    __device__ __forceinline__ const unsigned short* KA() const { return (const unsigned short*)(ws + WS_KA); }
    __device__ __forceinline__ const unsigned short* VA() const { return (const unsigned short*)(ws + WS_VA); }
    __device__ __forceinline__ const unsigned short* MKV() const { return (const unsigned short*)(ws + WS_MKV); }
    __device__ __forceinline__ const float* CS2() const { return (const float*)(ws + WS_CS2); }
    __device__ __forceinline__ unsigned short* U() const { return (unsigned short*)(ws + WS_U); }
    __device__ __forceinline__ unsigned short* U2() const { return (unsigned short*)(ws + WS_END + 2 * MiB); }
};
struct Desc { int kind, b, h, qb, T0, NT, dummy, s0, early, after; };
struct Geo { const unsigned short* Ksrc; const unsigned short* Vsrc; const float* csrow; int pitch; };

__device__ __forceinline__ Desc decode(int u, const ALAS int* t0tab) {
    Desc d; d.dummy = 0; d.s0 = 0; d.early = 0; d.after = 0;
#if defined(PROBE_REPEAT)
    int forceband = 0; if ((PROBE_REPEAT == 12 || PROBE_REPEAT == 13 || PROBE_REPEAT == 14 || (PROBE_REPEAT >= 40 && PROBE_REPEAT < 50)) && u >= N_UNITS) { u -= N_UNITS; d.dummy = 1; forceband = (PROBE_REPEAT == 12); }
    if (PROBE_REPEAT == 7 && u >= N_UNITS) u = 512 + (u - N_UNITS); if (PROBE_REPEAT == 8 && u >= N_UNITS) u = u - N_UNITS; if (PROBE_REPEAT == 11 && u >= N_UNITS) u = 384 + (u - N_UNITS);
#endif
    if (u < 384) { if (LPT_SORT) u = __builtin_amdgcn_readfirstlane(t0tab[384 + u]);
        const int bh = u % 24; d.kind = 1; d.qb = 15 - u / 24; d.b = bh / 12; d.h = bh % 12; d.T0 = __builtin_amdgcn_readfirstlane(t0tab[bh * 16 + d.qb]);
#if defined(PROBE_REPEAT)
        if (PROBE_REPEAT == 9) d.T0 = 0;
        if (PROBE_REPEAT == 10) { d.T0 -= 8; if (d.T0 < 0) d.T0 = 0; }
        if (forceband) d.T0 = d.qb * 4;
        if (PROBE_REPEAT == 50 || PROBE_REPEAT == 67) { const int fnt = __builtin_amdgcn_readfirstlane(t0tab[1152]); if (fnt > 0) { d.T0 = d.qb * 4 + 4 - fnt; if (d.T0 < 0) d.T0 = 0; } }
#endif
        d.NT = d.qb * 4 + 4 - d.T0; if (B128 && (d.NT & 1)) { d.T0 -= 1; d.NT += 1; } }
    else if (u >= C_FIRST && u < C_FIRST + 128) { const int v = u - C_FIRST, bh = v % 8; d.kind = 2; d.qb = v / 8; d.b = bh / 4; d.h = bh % 4; d.T0 = 0; d.NT = MEMT / 64; }
    else { const int v = (u < C_FIRST) ? u - 384 : u - 512, bh = v % 24; d.kind = 0; d.qb = v / 24; d.b = bh / 12; d.h = bh % 12; d.T0 = d.qb * 4 - 2; if (d.T0 < 0) d.T0 = 0; d.NT = d.qb * 4 + 4 - d.T0; }
    return d;
}
__device__ __forceinline__ Geo geo(const Tensors& T, const Desc& d) {
    Geo g;
    if (d.kind == 0) { const int kvh = d.h / 3; g.Ksrc = T.KA() + (size_t)(d.b * 4 + kvh) * 64 * 4096; g.Vsrc = T.VA() + (size_t)(d.b * 4 + kvh) * 64 * 4096; g.pitch = 0; g.csrow = T.CS2(); }
    else if (d.kind == 1) { g.Ksrc = T.KB() + (size_t)(d.b * 12 + d.h) * 64 * 4096; g.Vsrc = T.VB() + (size_t)(d.b * 12 + d.h) * 64 * 4096; g.pitch = 0; g.csrow = T.CS2() + ((size_t)d.b * 12 + d.h) * SEQ; }
    else { g.Ksrc = T.MKV() + (size_t)(d.b * 4 + d.h) * 4 * 8192; g.Vsrc = g.Ksrc + 262144; g.pitch = 0; g.csrow = T.CS2(); }
    return g;
}
__device__ __forceinline__ void issue_tile(const Geo& g, int kind, int tile, int s, unsigned lds0, int wid, int lane) {
    const size_t kr = (size_t)tile * 64;
    if (kind != 2) {
        const size_t to = (size_t)tile * 4096 + wid * 512 + lane * 8;
        glds16(g.Ksrc + to, (unsigned)__builtin_amdgcn_readfirstlane((int)(lds0 + LDS_K + s * 8192 + wid * 1024)));
        glds16(g.Vsrc + to, (unsigned)__builtin_amdgcn_readfirstlane((int)(lds0 + LDS_V + s * 8192 + wid * 1024)));
        if (kind == 1 && wid == 0) glds4(g.csrow + kr + lane, (unsigned)__builtin_amdgcn_readfirstlane((int)(lds0 + LDS_C + s * 256)));
    } else {
#pragma unroll
        for (int c = 0; c < 2; ++c) { const int p = wid + 8 * c;
            const size_t to = (size_t)tile * 8192 + p * 512 + lane * 8;
            glds16(g.Ksrc + to, (unsigned)__builtin_amdgcn_readfirstlane((int)(lds0 + LDS_K + s * 16384 + p * 1024)));
            glds16(g.Vsrc + to, (unsigned)__builtin_amdgcn_readfirstlane((int)(lds0 + LDS_V + s * 16384 + p * 1024))); }
    }
}
__device__ __forceinline__ void issue_pair(const Geo& g, int kind, int last, int pr, int s, unsigned lds0, int wid, int lane) {
    const int tlo = last - 2 * pr - 1;
#pragma unroll
    for (int img = 0; img < 2; ++img) { const size_t to = (size_t)(tlo + img) * 4096 + wid * 512 + lane * 8;
        glds16(g.Ksrc + to, (unsigned)__builtin_amdgcn_readfirstlane((int)(lds0 + LDS_K + s * 16384 + img * 8192 + wid * 1024)));
        glds16(g.Vsrc + to, (unsigned)__builtin_amdgcn_readfirstlane((int)(lds0 + LDS_V + s * 16384 + img * 8192 + wid * 1024))); }
    if (kind == 1 && wid == 0) { glds4(g.csrow + (size_t)tlo * 64 + lane, (unsigned)__builtin_amdgcn_readfirstlane((int)(lds0 + LDS_C + s * 512)));
                    glds4(g.csrow + (size_t)tlo * 64 + 64 + lane, (unsigned)__builtin_amdgcn_readfirstlane((int)(lds0 + LDS_C + s * 512 + 256))); }
}
__device__ __forceinline__ void issue_head(const Tensors& T, const Geo& g, const Desc& d, unsigned lds0, int wid, int lane) {
    const int last = d.T0 + d.NT - 1;
    if (d.kind != 2) {
        const unsigned short* qb = (d.kind == 0 ? T.QA() : T.QB()) + ((size_t)(d.b * 12 + d.h) * SEQ + d.qb * 256 + wid * 32) * 64;
#pragma unroll
        for (int i = 0; i < 4; ++i) glds16(qb + (i * 8 + (lane >> 3)) * 64 + (((lane & 7) ^ (lane >> 3)) * 8), (unsigned)__builtin_amdgcn_readfirstlane((int)(lds0 + LDS_Q + wid * 4096 + i * 1024)));
        if (d.kind == 1) glds4(T.CS2() + ((size_t)d.b * 12 + d.h) * SEQ + d.qb * 256 + wid * 32 + lane, (unsigned)__builtin_amdgcn_readfirstlane((int)(lds0 + LDS_CSQ + wid * 256)));
        issue_pair(g, d.kind, last, 0, d.s0, lds0, wid, lane);
    } else issue_tile(g, 2, last, d.s0, lds0, wid, lane);
}
__device__ __forceinline__ void issue_rest(const Geo& g, const Desc& d, unsigned lds0, int wid, int lane) {
    if (d.kind != 2 && d.NT > 2) issue_pair(g, d.kind, d.T0 + d.NT - 1, 1, d.s0 ^ 1, lds0, wid, lane);
}

template <int KIND, int ABL = 0> __device__ __forceinline__ void unit(const Tensors& T, const Desc& dsc, ALAS unsigned char* lds, volatile ALAS unsigned* misc, unsigned nidx, int n_total, int& next_u, Desc& nd) {
    constexpr int DH = (KIND == 2) ? 128 : 64, ND = DH / 16, NO = DH / 32;
    constexpr bool RING = (KIND != 2);
    constexpr int SLOT = RING ? 8192 : 16384;
    int tid = threadIdx.x; asm volatile("" : "+v"(tid));
    const int lane = tid & 63, r32 = lane & 31, hi = lane >> 5; const int wid = __builtin_amdgcn_readfirstlane(tid >> 6);
    unsigned qnext = 1u;
    const int b = dsc.b, h = dsc.h, q0 = dsc.qb * 256, T0 = dsc.T0, NT = dsc.NT; const size_t rowbase = (size_t)b * SEQ;
    const int qabs = q0 + wid * 32 + r32;
    const Geo g = geo(T, dsc);
    const int ucol = (KIND == 0) ? h * 64 : (KIND == 1) ? 768 + h * 64 : 1536 + h * 128;
    const int qzp = (KIND == 2) ? PGW : 64;
    const unsigned short* qbase_ = (KIND == 0) ? T.QA() + ((size_t)(b * 12 + h) * SEQ + q0 + wid * 32) * 64 : (KIND == 1) ? T.QB() + ((size_t)(b * 12 + h) * SEQ + q0 + wid * 32) * 64 : T.PG() + (rowbase + q0 + wid * 32) * PGW + PG_QC + h * 128;
    const unsigned short* zrow_ = (KIND == 0) ? T.ZA() + ((size_t)(b * 12 + h) * SEQ + q0 + wid * 32) * 64 : (KIND == 1) ? T.ZB() + ((size_t)(b * 12 + h) * SEQ + q0 + wid * 32) * 64 : T.PG() + (rowbase + q0 + wid * 32) * PGW + PG_ZC + h * 128;
    const unsigned short* qbase = qbase_; const unsigned short* zrow = zrow_;
#if defined(PROBE_REPEAT)
    if (T.pflag && (PROBE_REPEAT == 55 || PROBE_REPEAT == 56 || PROBE_REPEAT == 64)) { qbase = T.QA() + (size_t)(wid * 32) * 64; }
    if (T.pflag && (PROBE_REPEAT == 55 || PROBE_REPEAT == 57 || PROBE_REPEAT == 64)) { zrow = T.ZA() + (size_t)(wid * 32) * 64; }
#endif
    const unsigned lds0 = (unsigned)(size_t)lds;
    auto knorm = [&](int s) {
        const int row = tid >> 3, c0 = (tid & 7) * 2; ALAS unsigned char* kb = lds + LDS_K + s * SLOT + row * 16;
        bf16x8 a = *(const ALAS bf16x8*)(kb + c0 * 1024), c = *(const ALAS bf16x8*)(kb + (c0 + 1) * 1024);
        float fa[8], fc[8]; float ss = 0.f;
#pragma unroll
        for (int j = 0; j < 8; ++j) { fa[j] = __uint_as_float((unsigned)(unsigned short)a[j] << 16); fc[j] = __uint_as_float((unsigned)(unsigned short)c[j] << 16); ss += fa[j] * fa[j] + fc[j] * fc[j]; }
        ss += __builtin_bit_cast(float, __builtin_amdgcn_ds_swizzle(__builtin_bit_cast(int, ss), (1 << 10) | 0x1f)); ss += __builtin_bit_cast(float, __builtin_amdgcn_ds_swizzle(__builtin_bit_cast(int, ss), (2 << 10) | 0x1f));
        ss += __builtin_bit_cast(float, __builtin_amdgcn_ds_swizzle(__builtin_bit_cast(int, ss), (4 << 10) | 0x1f));
        const float rk = __builtin_amdgcn_rsqf(ss * (1.f / 128.f) + EPS);
        const f32x4 g0 = *(const f32x4*)(T.g_kc + c0 * 8), g1 = *(const f32x4*)(T.g_kc + c0 * 8 + 4), g2 = *(const f32x4*)(T.g_kc + c0 * 8 + 8), g3 = *(const f32x4*)(T.g_kc + c0 * 8 + 12);
        u32x4 oa, oc;
        oa.x = cvtpk(fa[0] * rk * g0[0], fa[1] * rk * g0[1]); oa.y = cvtpk(fa[2] * rk * g0[2], fa[3] * rk * g0[3]); oa.z = cvtpk(fa[4] * rk * g1[0], fa[5] * rk * g1[1]); oa.w = cvtpk(fa[6] * rk * g1[2], fa[7] * rk * g1[3]);
        oc.x = cvtpk(fc[0] * rk * g2[0], fc[1] * rk * g2[1]); oc.y = cvtpk(fc[2] * rk * g2[2], fc[3] * rk * g2[3]); oc.z = cvtpk(fc[4] * rk * g3[0], fc[5] * rk * g3[1]); oc.w = cvtpk(fc[6] * rk * g3[2], fc[7] * rk * g3[3]);
        *(ALAS u32x4*)(kb + c0 * 1024) = oa; *(ALAS u32x4*)(kb + (c0 + 1) * 1024) = oc;
    };
    bf16x8 qr[ND]; float csq = 0.f;
    if (KIND != 2) {
        switch (dsc.after) { case 4: asm volatile("s_waitcnt vmcnt(4)" ::: "memory"); break; case 8: asm volatile("s_waitcnt vmcnt(8)" ::: "memory"); break; case 10: asm volatile("s_waitcnt vmcnt(10)" ::: "memory"); break;
                             case 12: asm volatile("s_waitcnt vmcnt(12)" ::: "memory"); break; case 14: asm volatile("s_waitcnt vmcnt(14)" ::: "memory"); break; default: asm volatile("s_waitcnt vmcnt(0)" ::: "memory"); break; }
#pragma unroll
        for (int d0 = 0; d0 < ND; ++d0) qr[d0] = *(const ALAS bf16x8*)(lds + LDS_Q + wid * 4096 + r32 * 128 + (((2 * d0 + hi) ^ (r32 & 7)) * 16));
        if (KIND == 1) csq = *(const ALAS float*)(lds + LDS_CSQ + wid * 256 + r32 * 4);
#pragma unroll
        for (int i = 0; i < 4; ++i) glds16(zrow + i * 512 + lane * 8, (unsigned)__builtin_amdgcn_readfirstlane((int)(lds0 + LDS_OST + wid * 4096 + i * 1024)));
    } else {
        const unsigned short* Qw = qbase + (size_t)r32 * qzp + hi * 8;
#pragma unroll
        for (int d0 = 0; d0 < ND; ++d0) qr[d0] = *(const bf16x8*)(Qw + d0 * 16);
    }
    if (tid == 0) { typedef __attribute__((address_space(1))) unsigned gu32a; gu32a* qp = (gu32a*)T.qctr; asm volatile("" : "+v"(qp));
        qnext = __hip_atomic_fetch_add(qp, 1u, __ATOMIC_RELAXED, __HIP_MEMORY_SCOPE_AGENT); }
    if (KIND == 2) {
        float ss = 0.f;
#pragma unroll
        for (int d0 = 0; d0 < ND; ++d0)
#pragma unroll
            for (int j = 0; j < 8; ++j) { const float f = __uint_as_float((unsigned)(unsigned short)qr[d0][j] << 16); ss += f * f; }
        ss = pair_sum(ss);
        const float rq = C2_128 * __builtin_amdgcn_rsqf(ss * (1.f / 128.f) + EPS);
#pragma unroll
        for (int d0 = 0; d0 < ND; ++d0) { const f32x4 g0 = *(const f32x4*)(T.g_qc + d0 * 16 + hi * 8), g1 = *(const f32x4*)(T.g_qc + d0 * 16 + hi * 8 + 4); u32x4 w;
            float f[8];
#pragma unroll
            for (int j = 0; j < 8; ++j) f[j] = __uint_as_float((unsigned)(unsigned short)qr[d0][j] << 16) * rq;
            w.x = cvtpk(f[0] * g0[0], f[1] * g0[1]); w.y = cvtpk(f[2] * g0[2], f[3] * g0[3]); w.z = cvtpk(f[4] * g1[0], f[5] * g1[1]); w.w = cvtpk(f[6] * g1[2], f[7] * g1[3]);
            qr[d0] = __builtin_bit_cast(bf16x8, w); }
    }
#if defined(THR_TEST)
    constexpr float THR = -1000.f;
#else
    constexpr float THR = 8.f;
#endif
    float slope2 = 0.f, mref = 0.f; bool started = (KIND == 0);
    if (KIND == 0) { slope2 = __builtin_amdgcn_exp2f(-8.f * (float)(h + 1) * (1.f / 12.f)) * LOG2E; mref = ((const ALAS float*)T.t0tab)[1160 + h] * LOG2E; }
    f32x16 o[NO], lacc;
#pragma unroll
    for (int d = 0; d < NO; ++d) o[d] = f32x16{};
    { float l0 = (KIND == 0) ? 1.f : 0.f; asm volatile("" : "+v"(l0));
#pragma unroll
      for (int r = 0; r < 16; ++r) lacc[r] = l0; }
    const bf16x8 ones = (bf16x8){0x3f80, 0x3f80, 0x3f80, 0x3f80, 0x3f80, 0x3f80, 0x3f80, 0x3f80};
    ALAS float* wsf = (ALAS float*)(lds + LDS_WS) + wid * 64;
    const int vbl = ((lane >> 4) & 1) * 32 + (lane & 3) * 8 + (4 * hi + ((lane & 15) >> 2)) * 64;
#pragma unroll
    for (int d0 = 0; d0 < ND; ++d0) asm volatile("" : "+v"(qr[d0]));
    asm volatile("" : "+v"(csq), "+v"(mref), "+v"(slope2));
    if (!RING) { WAIT_BAR(0); }
    const int wq0 = q0 + wid * 32;
    int tlo = T0, thi = T0 + NT - 1;
    if (KIND == 0) { int a = wq0 - 127; a = a < 0 ? 0 : a; tlo = a >> 6; thi = (wq0 + 31) >> 6; }
    if (KIND == 1) { thi = (wq0 + 31) >> 6; }
    u32x4 pw[4];
    auto QKI = [&](f32x16& p0, f32x16& p1, int t) {
        const int tile = T0 + NT - 1 - t, s = RING ? (t & 3) : ((t + dsc.s0) & 1); const ALAS unsigned char* kp = lds + LDS_K + s * SLOT + hi * 1024 + r32 * 16;
            const int kb0 = tile * 64 + 4 * hi;
            if (KIND == 1) { const ALAS f32x4* cs4 = (const ALAS f32x4*)(lds + LDS_C + s * 256); const float cm = csq - mref;
#pragma unroll
                for (int gg = 0; gg < 4; ++gg) { const f32x4 c0 = cs4[2 * gg + hi], c1 = cs4[8 + 2 * gg + hi];
#pragma unroll
                    for (int j = 0; j < 4; ++j) { p0[4 * gg + j] = cm - c0[j]; p1[4 * gg + j] = cm - c1[j]; } } }
            else if (KIND == 0) { const float base = -slope2 * (float)(qabs - kb0) - mref, s32 = 32.f * slope2;
#pragma unroll
                for (int gg = 0; gg < 4; ++gg) { const float bg = __builtin_fmaf(slope2, (float)(8 * gg), base);
#pragma unroll
                    for (int j = 0; j < 4; ++j) { const float v = __builtin_fmaf(slope2, (float)j, bg); p0[4 * gg + j] = v; p1[4 * gg + j] = v + s32; } } }
            else {
#pragma unroll
                for (int r = 0; r < 16; ++r) { p0[r] = -mref; p1[r] = -mref; } }
            __builtin_amdgcn_sched_barrier(0);
    };
    auto QKM = [&](f32x16& p0, f32x16& p1, int t) {
        const int s = RING ? (t & 3) : ((t + dsc.s0) & 1); const ALAS unsigned char* kp = lds + LDS_K + s * SLOT + hi * 1024 + r32 * 16;
#pragma unroll
        for (int hb = 0; hb < ND / 2; ++hb) {
            bf16x8 kf[4];
#pragma unroll
            for (int d0 = 0; d0 < 2; ++d0) { kf[2 * d0] = *(const ALAS bf16x8*)(kp + (2 * hb + d0) * 2048); kf[2 * d0 + 1] = *(const ALAS bf16x8*)(kp + (2 * hb + d0) * 2048 + 512); }
#pragma unroll
            for (int d0 = 0; d0 < 2; ++d0) { p0 = __builtin_amdgcn_mfma_f32_32x32x16_bf16(kf[2 * d0], qr[2 * hb + d0], p0, 0, 0, 0); p1 = __builtin_amdgcn_mfma_f32_32x32x16_bf16(kf[2 * d0 + 1], qr[2 * hb + d0], p1, 0, 0, 0); }
        }
    };
    auto POST = [&](f32x16& p0, f32x16& p1, int t) -> bool {
        const int tile = T0 + NT - 1 - t; const int kb0 = tile * 64 + 4 * hi;
            if (KIND == 1) { if (tile * 64 + 63 > wq0) {
#pragma unroll
                for (int r = 0; r < 16; ++r) { const int kv = kb0 + (r & 3) + 8 * (r >> 2); if (kv > qabs) p0[r] = -INFINITY; if (kv + 32 > qabs) p1[r] = -INFINITY; } } }
            if (KIND == 0) {
#pragma unroll
                for (int r = 0; r < 16; ++r) { const int rel = qabs - (kb0 + (r & 3) + 8 * (r >> 2)); if (rel < 0 || rel >= 128) p0[r] = -INFINITY; if (rel - 32 < 0 || rel - 32 >= 128) p1[r] = -INFINITY; } }
            const float rm = rowmax(p0, p1);
            if (KIND == 1 && started && __all(rm < -40.f)) return true;
            if (!started || __any(rm > THR)) {
                const float dl = started ? __builtin_fmaxf(rm, 0.f) : (rm > -1e30f ? rm : 0.f);
                mref += dl;
#pragma unroll
                for (int r = 0; r < 16; ++r) { p0[r] -= dl; p1[r] -= dl; }
                if (started) {
                    if (hi == 0) wsf[r32] = __builtin_amdgcn_exp2f(-dl);
                    f32x4 a4[4];
#pragma unroll
                    for (int gg = 0; gg < 4; ++gg) a4[gg] = *(const ALAS f32x4*)(wsf + 8 * gg + 4 * hi);
#pragma unroll
                    for (int r = 0; r < 16; ++r) lacc[r] *= a4[r >> 2][r & 3];
#pragma unroll
                    for (int d = 0; d < NO; ++d)
#pragma unroll
                        for (int r = 0; r < 16; ++r) o[d][r] *= a4[r >> 2][r & 3]; }
                started = true; }
        return false;
    };
    auto EXPP = [&](f32x16& p0, f32x16& p1) {
#pragma unroll
            for (int r = 0; r < 16; ++r) { p0[r] = __builtin_amdgcn_exp2f(p0[r]); p1[r] = __builtin_amdgcn_exp2f(p1[r]); }
            pw[0] = (u32x4){cvtpk(p0[0], p0[1]), cvtpk(p0[2], p0[3]), cvtpk(p0[4], p0[5]), cvtpk(p0[6], p0[7])}; pw[1] = (u32x4){cvtpk(p0[8], p0[9]), cvtpk(p0[10], p0[11]), cvtpk(p0[12], p0[13]), cvtpk(p0[14], p0[15])};
            pw[2] = (u32x4){cvtpk(p1[0], p1[1]), cvtpk(p1[2], p1[3]), cvtpk(p1[4], p1[5]), cvtpk(p1[6], p1[7])}; pw[3] = (u32x4){cvtpk(p1[8], p1[9]), cvtpk(p1[10], p1[11]), cvtpk(p1[12], p1[13]), cvtpk(p1[14], p1[15])};
    };
    auto PV = [&](int t) {
        const int s = RING ? (t & 3) : ((t + dsc.s0) & 1);
            const ALAS unsigned char* vp = lds + LDS_V + s * SLOT + vbl;
            s16x4 vlo[8], vhi[8];
            __builtin_amdgcn_sched_barrier(0);
#pragma unroll
            for (int i = 0; i < 4; ++i) { vlo[i] = vtr(vp + (i >> 2) * 4096 + (i & 3) * 1024); vhi[i] = vtr(vp + (i >> 2) * 4096 + (i & 3) * 1024 + 512); }
            __builtin_amdgcn_sched_barrier(0);
            __builtin_amdgcn_sched_barrier(0);
#pragma unroll
            for (int i = 4; i < 8; ++i) { vlo[i] = vtr(vp + (i >> 2) * 4096 + (i & 3) * 1024); vhi[i] = vtr(vp + (i >> 2) * 4096 + (i & 3) * 1024 + 512); }
#pragma unroll
            for (int ks = 0; ks < 4; ++ks) lacc = __builtin_amdgcn_mfma_f32_32x32x16_bf16(__builtin_bit_cast(bf16x8, pw[ks]), ones, lacc, 0, 0, 0);
#pragma unroll
            for (int i = 0; i < 8; ++i) { const bf16x8 vf = (bf16x8){vlo[i][0], vlo[i][1], vlo[i][2], vlo[i][3], vhi[i][0], vhi[i][1], vhi[i][2], vhi[i][3]};
                o[i >> 2] = __builtin_amdgcn_mfma_f32_32x32x16_bf16(__builtin_bit_cast(bf16x8, pw[i & 3]), vf, o[i >> 2], 0, 0, 0); }
            if (NO > 2) {
#pragma unroll
                for (int i = 0; i < 8; ++i) { vlo[i] = vtr(vp + (2 + (i >> 2)) * 4096 + (i & 3) * 1024); vhi[i] = vtr(vp + (2 + (i >> 2)) * 4096 + (i & 3) * 1024 + 512); }
#pragma unroll
                for (int i = 0; i < 8; ++i) { const bf16x8 vf = (bf16x8){vlo[i][0], vlo[i][1], vlo[i][2], vlo[i][3], vhi[i][0], vhi[i][1], vhi[i][2], vhi[i][3]};
                    o[(NO > 2 ? 2 : 0) + (i >> 2)] = __builtin_amdgcn_mfma_f32_32x32x16_bf16(__builtin_bit_cast(bf16x8, pw[i & 3]), vf, o[(NO > 2 ? 2 : 0) + (i >> 2)], 0, 0, 0); } }
    };
    auto BOTH = [&](f32x16& n0, f32x16& n1, f32x16& c0, f32x16& c1, int tn) {
        const ALAS unsigned char* kp = lds + LDS_K + (tn & 3) * SLOT + hi * 1024 + r32 * 16;
        bf16x8 ka = *(const ALAS bf16x8*)(kp), kb = *(const ALAS bf16x8*)(kp + 512);
#pragma unroll
        for (int d0 = 0; d0 < 4; ++d0) {
            n0 = __builtin_amdgcn_mfma_f32_32x32x16_bf16(ka, qr[d0], n0, 0, 0, 0);
            if (d0 < 3) ka = *(const ALAS bf16x8*)(kp + (d0 + 1) * 2048);
#pragma unroll
            for (int r = 4 * d0; r < 4 * d0 + 4; ++r) c0[r] = __builtin_amdgcn_exp2f(c0[r]);
            { const unsigned a = cvtpk(c0[4 * d0], c0[4 * d0 + 1]), b = cvtpk(c0[4 * d0 + 2], c0[4 * d0 + 3]); if (d0 & 1) { pw[d0 >> 1].z = a; pw[d0 >> 1].w = b; } else { pw[d0 >> 1].x = a; pw[d0 >> 1].y = b; } }
            n1 = __builtin_amdgcn_mfma_f32_32x32x16_bf16(kb, qr[d0], n1, 0, 0, 0);
            if (d0 < 3) kb = *(const ALAS bf16x8*)(kp + (d0 + 1) * 2048 + 512);
#pragma unroll
            for (int r = 4 * d0; r < 4 * d0 + 4; ++r) c1[r] = __builtin_amdgcn_exp2f(c1[r]);
            { const unsigned a = cvtpk(c1[4 * d0], c1[4 * d0 + 1]), b = cvtpk(c1[4 * d0 + 2], c1[4 * d0 + 3]); if (d0 & 1) { pw[2 + (d0 >> 1)].z = a; pw[2 + (d0 >> 1)].w = b; } else { pw[2 + (d0 >> 1)].x = a; pw[2 + (d0 >> 1)].y = b; } }
        }
    };
    const int ta = (T0 + NT - 1) - thi, tb = (T0 + NT - 1) - tlo;
    bool pub = false;
    if (B128 && KIND != 2) {
        int NPR = NT / 2; const int last = T0 + NT - 1;
#if defined(PROBE_REPEAT)
        if (T.pflag && (PROBE_REPEAT == 61 || PROBE_REPEAT == 63)) NPR = 0;
#endif
        f32x16 pL0, pL1, pH0, pH1; u32x4 pw[8];
        for (int t = 0; t < NPR; ++t) {
            const int s = (t + dsc.s0) & 1, tl = last - 2 * t - 1;
            const bool lastst = (EARLY_HEAD & 1) && (t == NPR - 1) && (NPR >= 2);
            if (t == 0) LGKM_BAR();
            else if (lastst) { asm volatile("s_waitcnt vmcnt(0)" ::: "memory"); if (tid == 0) misc[24] = qnext + T.q_lo; LGKM_BAR(); }
            else WAIT_BAR(0);
            if (t >= 1 && t + 1 < NPR) issue_pair(g, KIND, last, t + 1, (t + 1 + dsc.s0) & 1, lds0, wid, lane);
            if (lastst) { next_u = __builtin_amdgcn_readfirstlane((int)misc[24]); pub = true;
                if (next_u < n_total) { nd = decode(PROBE_MAP(next_u), T.t0tab); nd.s0 = (t + 1 + dsc.s0) & 1; nd.early = 1; const Geo ng = geo(T, nd); if (!(EARLY_HEAD & 4)) issue_head(T, ng, nd, lds0, wid, lane); } }
            if (tl <= thi && tl + 1 >= tlo) {
                const ALAS unsigned char* kpL = lds + LDS_K + s * 16384 + hi * 1024 + r32 * 16; const ALAS unsigned char* kpH = kpL + 8192;
                const int kbL = tl * 64 + 4 * hi, kbH = kbL + 64;
                if (KIND == 0) { const float base = -slope2 * (float)(qabs - kbL) - mref, s32 = 32.f * slope2, s64 = 64.f * slope2;
#pragma unroll
                    for (int gg = 0; gg < 4; ++gg) { const float bg = __builtin_fmaf(slope2, (float)(8 * gg), base);
#pragma unroll
                        for (int j = 0; j < 4; ++j) { const float v = __builtin_fmaf(slope2, (float)j, bg); pL0[4 * gg + j] = v; pL1[4 * gg + j] = v + s32; pH0[4 * gg + j] = v + s64; pH1[4 * gg + j] = v + s64 + s32; } } }
                else { const ALAS f32x4* cs4 = (const ALAS f32x4*)(lds + LDS_C + s * 512); const float cm = csq - mref;
#pragma unroll
                  for (int gg = 0; gg < 4; ++gg) { const f32x4 a0 = cs4[2 * gg + hi], a1 = cs4[8 + 2 * gg + hi], b0 = cs4[16 + 2 * gg + hi], b1 = cs4[24 + 2 * gg + hi];
#pragma unroll
                      for (int j = 0; j < 4; ++j) { pL0[4 * gg + j] = cm - a0[j]; pL1[4 * gg + j] = cm - a1[j]; pH0[4 * gg + j] = cm - b0[j]; pH1[4 * gg + j] = cm - b1[j]; } } }
                { bf16x8 ka = *(const ALAS bf16x8*)(kpL), kb = *(const ALAS bf16x8*)(kpL + 512), kc = *(const ALAS bf16x8*)(kpH), kd = *(const ALAS bf16x8*)(kpH + 512);
#pragma unroll
                  for (int d0 = 0; d0 < 4; ++d0) {
                      pL0 = __builtin_amdgcn_mfma_f32_32x32x16_bf16(ka, qr[d0], pL0, 0, 0, 0); if (d0 < 3) ka = *(const ALAS bf16x8*)(kpL + (d0 + 1) * 2048);
                      pL1 = __builtin_amdgcn_mfma_f32_32x32x16_bf16(kb, qr[d0], pL1, 0, 0, 0); if (d0 < 3) kb = *(const ALAS bf16x8*)(kpL + (d0 + 1) * 2048 + 512);
                      pH0 = __builtin_amdgcn_mfma_f32_32x32x16_bf16(kc, qr[d0], pH0, 0, 0, 0); if (d0 < 3) kc = *(const ALAS bf16x8*)(kpH + (d0 + 1) * 2048);
                      pH1 = __builtin_amdgcn_mfma_f32_32x32x16_bf16(kd, qr[d0], pH1, 0, 0, 0); if (d0 < 3) kd = *(const ALAS bf16x8*)(kpH + (d0 + 1) * 2048 + 512); } }
                if (KIND == 0) {
#pragma unroll
                    for (int r = 0; r < 16; ++r) { const int rel = qabs - (kbL + (r & 3) + 8 * (r >> 2));
                        if ((unsigned)rel >= 128u) pL0[r] = -INFINITY; if ((unsigned)(rel - 32) >= 128u) pL1[r] = -INFINITY; if ((unsigned)(rel - 64) >= 128u) pH0[r] = -INFINITY; if ((unsigned)(rel - 96) >= 128u) pH1[r] = -INFINITY; } }
                else if ((tl + 1) * 64 + 63 > wq0) {
#pragma unroll
                    for (int r = 0; r < 16; ++r) { const int kv = kbL + (r & 3) + 8 * (r >> 2);
                        if (kv > qabs) pL0[r] = -INFINITY; if (kv + 32 > qabs) pL1[r] = -INFINITY; if (kv + 64 > qabs) pH0[r] = -INFINITY; if (kv + 96 > qabs) pH1[r] = -INFINITY; } }
                (void)kbH;
                const float rm = __builtin_fmaxf(rowmax(pL0, pL1), rowmax(pH0, pH1));
                bool negl = false;
                if (KIND == 1 && started && __all(rm < -40.f)) negl = true;
                if (!negl) {
                if (!started || __any(rm > THR)) {
                    const float dl = started ? __builtin_fmaxf(rm, 0.f) : (rm > -1e30f ? rm : 0.f);
                    mref += dl;
#pragma unroll
                    for (int r = 0; r < 16; ++r) { pL0[r] -= dl; pL1[r] -= dl; pH0[r] -= dl; pH1[r] -= dl; }
                    if (started) {
                        if (hi == 0) wsf[r32] = __builtin_amdgcn_exp2f(-dl);
                        f32x4 a4[4];
#pragma unroll
                        for (int gg = 0; gg < 4; ++gg) a4[gg] = *(const ALAS f32x4*)(wsf + 8 * gg + 4 * hi);
#pragma unroll
                        for (int r = 0; r < 16; ++r) lacc[r] *= a4[r >> 2][r & 3];
#pragma unroll
                        for (int d = 0; d < NO; ++d)
#pragma unroll
                            for (int r = 0; r < 16; ++r) o[d][r] *= a4[r >> 2][r & 3]; }
                    started = true; }
                const ALAS unsigned char* vpL = lds + LDS_V + s * 16384 + vbl; const ALAS unsigned char* vpH = vpL + 8192;
                s16x4 vl[8], vh[8], wl[8], wh[8];
                __builtin_amdgcn_sched_barrier(0);
#pragma unroll
                for (int i = 0; i < 8; ++i) { vl[i] = vtr(vpL + (i >> 2) * 4096 + (i & 3) * 1024); vh[i] = vtr(vpL + (i >> 2) * 4096 + (i & 3) * 1024 + 512); }
                __builtin_amdgcn_sched_barrier(0);
#pragma unroll
                for (int r = 0; r < 16; ++r) { pL0[r] = __builtin_amdgcn_exp2f(pL0[r]); pL1[r] = __builtin_amdgcn_exp2f(pL1[r]); pH0[r] = __builtin_amdgcn_exp2f(pH0[r]); pH1[r] = __builtin_amdgcn_exp2f(pH1[r]); }
                pw[0] = (u32x4){cvtpk(pL0[0], pL0[1]), cvtpk(pL0[2], pL0[3]), cvtpk(pL0[4], pL0[5]), cvtpk(pL0[6], pL0[7])}; pw[1] = (u32x4){cvtpk(pL0[8], pL0[9]), cvtpk(pL0[10], pL0[11]), cvtpk(pL0[12], pL0[13]), cvtpk(pL0[14], pL0[15])};
                pw[2] = (u32x4){cvtpk(pL1[0], pL1[1]), cvtpk(pL1[2], pL1[3]), cvtpk(pL1[4], pL1[5]), cvtpk(pL1[6], pL1[7])}; pw[3] = (u32x4){cvtpk(pL1[8], pL1[9]), cvtpk(pL1[10], pL1[11]), cvtpk(pL1[12], pL1[13]), cvtpk(pL1[14], pL1[15])};
                pw[4] = (u32x4){cvtpk(pH0[0], pH0[1]), cvtpk(pH0[2], pH0[3]), cvtpk(pH0[4], pH0[5]), cvtpk(pH0[6], pH0[7])}; pw[5] = (u32x4){cvtpk(pH0[8], pH0[9]), cvtpk(pH0[10], pH0[11]), cvtpk(pH0[12], pH0[13]), cvtpk(pH0[14], pH0[15])};
                pw[6] = (u32x4){cvtpk(pH1[0], pH1[1]), cvtpk(pH1[2], pH1[3]), cvtpk(pH1[4], pH1[5]), cvtpk(pH1[6], pH1[7])}; pw[7] = (u32x4){cvtpk(pH1[8], pH1[9]), cvtpk(pH1[10], pH1[11]), cvtpk(pH1[12], pH1[13]), cvtpk(pH1[14], pH1[15])};
                __builtin_amdgcn_sched_barrier(0);
#pragma unroll
                for (int i = 0; i < 8; ++i) { wl[i] = vtr(vpH + (i >> 2) * 4096 + (i & 3) * 1024); wh[i] = vtr(vpH + (i >> 2) * 4096 + (i & 3) * 1024 + 512); }
#pragma unroll
                for (int k = 0; k < 8; ++k) lacc = __builtin_amdgcn_mfma_f32_32x32x16_bf16(__builtin_bit_cast(bf16x8, pw[k]), ones, lacc, 0, 0, 0);
#pragma unroll
                for (int i = 0; i < 8; ++i) { const bf16x8 vf = (bf16x8){vl[i][0], vl[i][1], vl[i][2], vl[i][3], vh[i][0], vh[i][1], vh[i][2], vh[i][3]};
                    o[i >> 2] = __builtin_amdgcn_mfma_f32_32x32x16_bf16(__builtin_bit_cast(bf16x8, pw[i & 3]), vf, o[i >> 2], 0, 0, 0); }
#pragma unroll
                for (int i = 0; i < 8; ++i) { const bf16x8 vf = (bf16x8){wl[i][0], wl[i][1], wl[i][2], wl[i][3], wh[i][0], wh[i][1], wh[i][2], wh[i][3]};
                    o[i >> 2] = __builtin_amdgcn_mfma_f32_32x32x16_bf16(__builtin_bit_cast(bf16x8, pw[4 + (i & 3)]), vf, o[i >> 2], 0, 0, 0); }
                }
            }
        }
    } else {
    constexpr bool PIPE = (KIND == 1);
    if (PIPE) {
        f32x16 pA0, pA1, pB0, pB1;
        bool skA = false, skB = false;
        auto STEP = [&](f32x16& c0, f32x16& c1, bool& skc, f32x16& n0, f32x16& n1, bool& skn, int t) {
            { const int li = (t < 0) ? 2 : (t == 0 ? 3 : t + 2); int nbh = (li < NT - 1 ? li : NT - 1) - (t + 1); if (nbh < 0) nbh = 0;
#if defined(PROBE_REPEAT)
              if (PROBE_REPEAT == 14 && dsc.dummy) { LGKM_BAR(); } else
#endif
              if (KIND == 1 && wid == 0) { if (nbh >= 2) WAIT_BAR(6); else if (nbh == 1) WAIT_BAR(3); else WAIT_BAR(0); }
              else { if (nbh >= 2) WAIT_BAR(4); else if (nbh == 1) WAIT_BAR(2); else WAIT_BAR(0); } }
            if (t < 0) { if (3 < NT) issue_tile(g, KIND, T0 + NT - 1 - 3, 3, lds0, wid, lane); }
            else if (t >= 1) { if (t + 3 < NT) issue_tile(g, KIND, T0 + NT - 1 - (t + 3), (t + 3) & 3, lds0, wid, lane); }
            const bool an = (t + 1 >= ta) && (t + 1 <= tb) && (t + 1 < NT), ac = (t >= ta) && (t <= tb) && (t >= 0) && !skc;
            if (ABL == 43) return;
            if (an && ABL != 44) QKI(n0, n1, t + 1);
            if (ABL == 41) { if (ac) EXPP(c0, c1); } else if (ABL == 45) { if (an) QKM(n0, n1, t + 1); } else { if (an && ac) BOTH(n0, n1, c0, c1, t + 1); else if (an) QKM(n0, n1, t + 1); else if (ac) EXPP(c0, c1); }
            if (ac && ABL != 40) PV(t);
            skn = false; if (an && ABL != 42) skn = POST(n0, n1, t + 1);
        };
        STEP(pB0, pB1, skB, pA0, pA1, skA, -1);
        for (int t = 0; t < NT; t += 2) {
            STEP(pA0, pA1, skA, pB0, pB1, skB, t);
            if (t + 1 < NT) STEP(pB0, pB1, skB, pA0, pA1, skA, t + 1);
        }
    } else if (RING) {
        f32x16 p0, p1;
        for (int t = 0; t < NT; ++t) {
            const int rem = NT - 1 - t;
            if (rem >= 2) WAIT_BAR(4); else if (rem == 1) WAIT_BAR(2); else WAIT_BAR(0);
            if (t + 3 < NT) issue_tile(g, KIND, T0 + NT - 1 - (t + 3), (t + 3) & 3, lds0, wid, lane);
            if (t >= ta && t <= tb) { QKI(p0, p1, t); QKM(p0, p1, t); (void)POST(p0, p1, t); EXPP(p0, p1); PV(t); }
        }
    } else {
        f32x16 p0, p1;
        for (int t = 0; t < NT; ++t) {
            if (t + 1 < NT) issue_tile(g, KIND, T0 + NT - 1 - (t + 1), (t + 1 + dsc.s0) & 1, lds0, wid, lane);
            else if (pub && next_u < n_total) { nd = decode(PROBE_MAP(next_u), T.t0tab); nd.s0 = (t + 1 + dsc.s0) & 1; nd.early = 1; const Geo ng = geo(T, nd); issue_head(T, ng, nd, lds0, wid, lane); }
            QKI(p0, p1, t); QKM(p0, p1, t); (void)POST(p0, p1, t); EXPP(p0, p1); PV(t);
            if ((EARLY_HEAD & 2) && t + 2 == NT) { asm volatile("s_waitcnt vmcnt(0)" ::: "memory"); if (tid == 0) misc[24] = qnext + T.q_lo; LGKM_BAR(); next_u = __builtin_amdgcn_readfirstlane((int)misc[24]); pub = true; }
            else if (t + 1 < NT) WAIT_BAR(0);
        }
    }
    }
    (void)nidx;
    if (!pub) { asm volatile("s_waitcnt vmcnt(0)" ::: "memory"); if (tid == 0) misc[24] = qnext + T.q_lo; }
    LGKM_BAR();
    if (!pub) next_u = __builtin_amdgcn_readfirstlane((int)misc[24]);
    if (next_u < n_total) {
        if (!pub) { nd = decode(PROBE_MAP(next_u), T.t0tab); nd.s0 = 0; nd.early = 0; }
        const Geo ng = geo(T, nd);
        if (!pub || (EARLY_HEAD & 4)) issue_head(T, ng, nd, lds0, wid, lane);
        issue_rest(ng, nd, lds0, wid, lane);
#if defined(PROBE_REPEAT) && (PROBE_REPEAT != -1)
        nd.after = 0;
#else
        nd.after = ((nd.kind != 2 && nd.NT > 2) ? 4 + ((nd.kind == 1 && wid == 0) ? 2 : 0) : 0) + ((KIND == 2) ? 8 : 4);
#endif
    }
#if defined(PROBE_REPEAT)
    if (T.pflag && (PROBE_REPEAT == 62 || PROBE_REPEAT == 63)) return;
#endif
    float rli[16];
#pragma unroll
    for (int r = 0; r < 16; ++r) rli[r] = __builtin_amdgcn_rcpf(lacc[r]);
    ALAS unsigned short* stg = (ALAS unsigned short*)(lds + LDS_OST) + wid * 2048;
    unsigned short* urow = (dsc.dummy ? T.U2() : T.U()) + (rowbase + q0 + wid * 32) * DM + ucol;
    u32x4 zq[NO / 2][4];
#pragma unroll
    for (int pass = 0; pass < NO / 2; ++pass)
#pragma unroll
        for (int i = 0; i < 4; ++i) { if (KIND != 2) zq[pass][i] = *(const ALAS u32x4*)(stg + (i * 8 + (lane >> 3)) * 64 + (lane & 7) * 8);
                                      else zq[pass][i] = *(const u32x4*)(zrow + (size_t)(i * 8 + (lane >> 3)) * qzp + pass * 64 + (lane & 7) * 8); }
    if (KIND != 2) asm volatile("s_waitcnt lgkmcnt(0)" ::: "memory");
    __builtin_amdgcn_sched_barrier(0);
#if defined(PROBE_REPEAT)
    if (T.pflag && PROBE_REPEAT == 66) { asm volatile("" :: "v"(zq[0][0]), "v"(zq[0][3]), "v"(rli[0]), "v"(rli[15])); return; }
#endif
#pragma unroll
    for (int pass = 0; pass < NO / 2; ++pass) {
#pragma unroll
        for (int r = 0; r < 16; ++r) { const int orow = crow(r, hi);
#pragma unroll
            for (int d = 0; d < 2; ++d) stg[orow * 64 + d * 32 + r32] = (unsigned short)(cvtpk(o[pass * 2 + d][r] * rli[r], 0.f) & 0xffffu); }
#pragma unroll
        for (int i = 0; i < 4; ++i) { const int row = i * 8 + (lane >> 3), ch = lane & 7;
            const u32x4 ov = *(const ALAS u32x4*)(stg + row * 64 + ch * 8); const u32x4 zv = zq[pass][i];
            u32x4 w;
            w.x = cvtpk(__uint_as_float(ov.x << 16) * __uint_as_float(zv.x << 16), __uint_as_float(ov.x & 0xffff0000u) * __uint_as_float(zv.x & 0xffff0000u));
            w.y = cvtpk(__uint_as_float(ov.y << 16) * __uint_as_float(zv.y << 16), __uint_as_float(ov.y & 0xffff0000u) * __uint_as_float(zv.y & 0xffff0000u));
            w.z = cvtpk(__uint_as_float(ov.z << 16) * __uint_as_float(zv.z << 16), __uint_as_float(ov.z & 0xffff0000u) * __uint_as_float(zv.z & 0xffff0000u));
            w.w = cvtpk(__uint_as_float(ov.w << 16) * __uint_as_float(zv.w << 16), __uint_as_float(ov.w & 0xffff0000u) * __uint_as_float(zv.w & 0xffff0000u));
#if defined(PROBE_REPEAT)
            if (T.pflag && PROBE_REPEAT == 65) { asm volatile("" :: "v"(w)); } else
#endif
            *(u32x4*)(urow + (size_t)row * DM + pass * 64 + ch * 8) = w; }
    }
}
#undef MX3
#undef WAIT_BAR
#undef LGKM_BAR
#undef ALAS
}

#ifndef PROBE_REPEAT
#define PROBE_REPEAT (-1)
#endif
#ifndef STATIC_FIRST
#define STATIC_FIRST 1
#endif
#ifndef FB_UNROLL
#define FB_UNROLL 3
#endif
#ifndef PROBE_WIN_LO
#define PROBE_WIN_LO 0
#define PROBE_WIN_HI 0
#endif
#ifndef P1_ALIGN
#define P1_ALIGN true
#endif
#ifndef P1_SP2
#define P1_SP2 true
#endif
#ifndef P1_WGM
#define P1_WGM 8
#endif

struct Frame {
    LAS unsigned char* lds;
    volatile LAS unsigned* MISC;
    gu32* ctl;
    int tid, lane, wave;
    int vcu, G;
};
__device__ __forceinline__ float wave_sum_f(float v) {
#ifdef OLD_WSUM
    for (int o = 1; o < 64; o <<= 1) v += __shfl_xor(v, o);
    return v;
#endif
    v += __builtin_bit_cast(float, __builtin_amdgcn_update_dpp(0, __builtin_bit_cast(int, v), 0xB1, 0xf, 0xf, false));
    v += __builtin_bit_cast(float, __builtin_amdgcn_update_dpp(0, __builtin_bit_cast(int, v), 0x4E, 0xf, 0xf, false));
    v += __builtin_bit_cast(float, __builtin_amdgcn_update_dpp(0, __builtin_bit_cast(int, v), 0x141, 0xf, 0xf, false));
    v += __builtin_bit_cast(float, __builtin_amdgcn_update_dpp(0, __builtin_bit_cast(int, v), 0x140, 0xf, 0xf, false));
    v += __builtin_bit_cast(float, __builtin_amdgcn_update_dpp(0, __builtin_bit_cast(int, v), 0x142, 0xa, 0xf, false));
    v += __builtin_bit_cast(float, __builtin_amdgcn_update_dpp(0, __builtin_bit_cast(int, v), 0x143, 0xc, 0xf, false));
    v = __builtin_bit_cast(float, __builtin_amdgcn_readlane(__builtin_bit_cast(int, v), 63));
    return v;
}
__device__ __forceinline__ void p0_item_load(f32x4 (&v)[8], const float* Wsrc, int ldw, int lane) {
#pragma unroll
    for (int i = 0; i < 8; ++i) v[i] = *(const GAS f32x4*)(Wsrc + (size_t)(8 * i + (lane >> 3)) * ldw + 4 * (lane & 7));
}
__device__ __forceinline__ void p0_item_finish(const f32x4 (&v)[8], bf16* dst, int ldd, LAS float* scr, int lane) {
#pragma unroll
    for (int i = 0; i < 8; ++i) { LAS float* d = scr + (8 * i + (lane >> 3)) * 33 + 4 * (lane & 7); d[0] = v[i].x; d[1] = v[i].y; d[2] = v[i].z; d[3] = v[i].w; }
    LDS_WAIT(); asm volatile("" ::: "memory");
    const int c = lane & 7;
#pragma unroll
    for (int j = 0; j < 4; ++j) { const int n = (lane >> 3) + 8 * j; const LAS float* s = scr + (8 * c) * 33 + n;
        v4u o; o.x = pk2(s[0 * 33], s[1 * 33]); o.y = pk2(s[2 * 33], s[3 * 33]); o.z = pk2(s[4 * 33], s[5 * 33]); o.w = pk2(s[6 * 33], s[7 * 33]);
        *(GAS v4u*)(dst + (size_t)n * ldd + 8 * c) = o; }
    LDS_WAIT(); asm volatile("" ::: "memory");
}
__device__ __forceinline__ void rms_row_load(f32x4 (&v)[8], const float* xrow, int lane) { const GAS f32x4* xr = (const GAS f32x4*)xrow + lane;
#pragma unroll
    for (int j = 0; j < 8; ++j) v[j] = xr[64 * j]; }
template <bool FB> __device__ __forceinline__ void rms_row(f32x4 (&v)[8], const f32x4 (&gn)[8], bf16* orow, int lane, const LAS f32x4* wfb4, const float* b_forget, float* lf_out  ) {
    float s = 0.f;
#pragma unroll
    for (int j = 0; j < 8; ++j) { s += (v[j].x * v[j].x + v[j].y * v[j].y) + (v[j].z * v[j].z + v[j].w * v[j].w); }
    const float rstd = 1.f / sqrtf(wave_sum_f(s) * (1.f / DM) + EPS);
    GAS unsigned long long* o8 = (GAS unsigned long long*)orow + lane;
#pragma unroll
    for (int j = 0; j < 8; ++j) { v[j] = v[j] * rstd * gn[j]; o8[64 * j] = (unsigned long long)pk2(v[j].x, v[j].y) | ((unsigned long long)pk2(v[j].z, v[j].w) << 32); }
    if constexpr (FB) {
        float mine = 0.f;
#pragma unroll FB_UNROLL
        for (int h = 0; h < 12; ++h) { float a = 0.f;
#pragma unroll
            for (int j = 0; j < 8; ++j) { const f32x4 w = wfb4[h * 512 + 64 * j + lane]; a += (v[j].x * w.x + v[j].y * w.y) + (v[j].z * w.z + v[j].w * w.w); }
            a = wave_sum_f(a); mine = (lane == h) ? a : mine; }
        if (lane < 12) lf_out[(size_t)lane * SEQ] = log_sigmoidf_(mine + b_forget[lane]);
    }
}
struct Args { const float* in[18]; float* out; unsigned char* ws; int ph_lo, ph_hi, li, pad; };

__device__ __forceinline__ void p0_prologue(Frame& F, const Args& args) {
    unsigned char* ws = args.ws;
    const float* x = args.in[0]; const float* mem = args.in[1]; const float* norm_gain = args.in[2]; const float* mem_norm_gain = args.in[3]; const float* w_in = args.in[4]; const float* b_forget = args.in[5];
    const float* w_mem_kv = args.in[13]; const float* w_br_a = args.in[14]; const float* w_br_b = args.in[15]; const float* w_br_c = args.in[16]; const float* w_out = args.in[17];
    bf16* HN = (bf16*)(ws + WS_HN); bf16* MEMN = (bf16*)(ws + WS_MEMN); float* LF = (float*)(ws + WS_LF);
    bf16* W1T = (bf16*)(ws + WS_W1T); bf16* WMKVT = (bf16*)(ws + WS_WMKVT); bf16* WBRT = (bf16*)(ws + WS_WBRT); bf16* WOUTT = (bf16*)(ws + WS_WOUTT);
    const int NPROD = (F.G > 16) ? 8 : 0; gu32* p0c = F.ctl + CW_P0MK;
    if ((int)blockIdx.x < NPROD) {
        if (((PROBE_REPEAT >= 71 && PROBE_REPEAT <= 76) || PROBE_REPEAT == 81) && args.pad) return;
        if (F.tid == 0) { unsigned sp = 0; while (__hip_atomic_load((unsigned*)p0c, __ATOMIC_RELAXED, __HIP_MEMORY_SCOPE_AGENT) < (unsigned)(F.G - NPROD)) { __builtin_amdgcn_s_sleep(8); if (++sp > (1u << 22)) break; }
            __builtin_amdgcn_fence(__ATOMIC_ACQUIRE, "agent"); VM_WAIT(); }
        __syncthreads();
        const int u = (int)blockIdx.x; bf16* MKV = (bf16*)(ws + WS_MKV);
        pg8::Gemm g{MEMN, WMKVT, MM, 1024, DM}; pg8::SingleOrder S{u >> 2, u & 3}; pg8::EpiMkv E{MKV, MKV + 262144, args.in[12], EPS};
        pg8::gemm_phase<pg8::EpiMkv, pg8::SingleOrder, false, true>(F.lds + RING_OFF, g, S, E);
        return;
    }
    int rank = F.vcu; { int below = 0; for (int pb = 0; pb < NPROD; ++pb) { const int pv = (F.G % 8 == 0) ? (pb % 8) * (F.G / 8) + pb / 8 : pb; below += (pv < F.vcu) ? 1 : 0; } rank -= below; }
    const int gw = rank * NWAVES + F.wave, NGW = (F.G - NPROD) * NWAVES;
    LAS float* scr = (LAS float*)(F.lds + RING_OFF + F.wave * 16384);
    constexpr int I_W1 = 32 * (NP / 32), I_MKV = 32 * 32, I_BR = 32 * 64, I_OUT = 32 * 64, NITEMS = I_W1 + I_BR + I_OUT;
    { f32x4 gm[8];
#pragma unroll
      for (int j = 0; j < 8; ++j) gm[j] = ((const f32x4*)mem_norm_gain)[F.lane + 64 * j];
      for (int m = gw; m < MM; m += NGW) { f32x4 vm[8]; rms_row_load(vm, mem + (size_t)m * DM, F.lane); rms_row<false>(vm, gm, MEMN + (size_t)m * DM, F.lane, nullptr, nullptr, nullptr); }
      for (int r = gw; r < I_MKV; r += NGW) { const int kb = r / 32, nb = r % 32, k0 = 64 * kb, n0 = 32 * nb; f32x4 vv[8];
          p0_item_load(vv, w_mem_kv + (size_t)k0 * 1024 + n0, 1024, F.lane); p0_item_finish(vv, WMKVT + (size_t)n0 * DM + k0, DM, scr, F.lane); } }
    VM_WAIT(); __syncthreads();
    if (F.tid == 0) { __builtin_amdgcn_fence(__ATOMIC_RELEASE, "agent"); VM_WAIT(); __hip_atomic_fetch_add((unsigned*)p0c, 1u, __ATOMIC_RELAXED, __HIP_MEMORY_SCOPE_AGENT); }
    if (PROBE_REPEAT == 73 && args.pad) return;
    LAS float* wfb = (LAS float*)(F.lds + RING_OFF);
    { f32x4 pv[12];
#pragma unroll
      for (int i = 0; i < 12; ++i) { const int pc = F.tid + i * (NWAVES * 64), k = pc / 3, part = pc % 3; pv[i] = *(const f32x4*)(w_in + (size_t)k * IN_W + SRC_FB + 4 * part); }
#pragma unroll
      for (int i = 0; i < 12; ++i) { const int pc = F.tid + i * (NWAVES * 64), k = pc / 3, part = pc % 3; LAS float* d = wfb + (4 * part) * DM + k; d[0] = pv[i].x; d[DM] = pv[i].y; d[2 * DM] = pv[i].z; d[3 * DM] = pv[i].w; } }
    __syncthreads();
    if (PROBE_REPEAT == 74 && args.pad) return;
    { f32x4 gn[8];
#pragma unroll
      for (int j = 0; j < 8; ++j) gn[j] = ((const f32x4*)norm_gain)[F.lane + 64 * j];
      { constexpr int NR = M * (PROBE_REPEAT == 0 ? 2 : 1);
        f32x4 va[8], vb[8];
        if (gw < NR) rms_row_load(va, x + (size_t)(gw % M) * DM, F.lane);
        for (int mm = gw; mm < NR; mm += 2 * NGW) {
            const bool h1 = mm + NGW < NR;
            if (h1) rms_row_load(vb, x + (size_t)((mm + NGW) % M) * DM, F.lane);
            { const int m = mm % M, b = m / SEQ, t = m % SEQ; rms_row<true>(va, gn, HN + (size_t)m * DM, F.lane, (const LAS f32x4*)wfb, b_forget, LF + (size_t)b * 12 * SEQ + t); }
            if (!h1) break;
            const bool h2 = mm + 2 * NGW < NR;
            if (h2) rms_row_load(va, x + (size_t)((mm + 2 * NGW) % M) * DM, F.lane);
            { const int m = (mm + NGW) % M, b = m / SEQ, t = m % SEQ; rms_row<true>(vb, gn, HN + (size_t)m * DM, F.lane, (const LAS f32x4*)wfb, b_forget, LF + (size_t)b * 12 * SEQ + t); }
            if (!h2) break;
        } }
    }
    __syncthreads();
    if (PROBE_REPEAT == 75 && args.pad) return;
    auto item_addr = [&](int it, const float*& src, int& ldw, bf16*& dst) {
        int r = it % NITEMS;
        if (r < I_W1) { const int kb = r / (NP / 32), nb = r % (NP / 32), k0 = 64 * kb, n0 = 32 * nb, sn = n0 + (n0 >= SRC_FB ? 12 : 0); src = w_in + (size_t)k0 * IN_W + sn; ldw = IN_W; dst = W1T + (size_t)n0 * DM + k0; return; } r -= I_W1;
        if (r < I_BR) { const int kb = r / 64, nb = r % 64, k0 = 64 * kb, n0 = 32 * nb;
            src = ((kb < 12) ? w_br_a + (size_t)k0 * DM : (kb < 24) ? w_br_b + (size_t)(k0 - 768) * DM : w_br_c + (size_t)(k0 - 1536) * DM) + n0; ldw = DM; dst = WBRT + (size_t)n0 * DM + k0; return; } r -= I_BR;
        { const int kb = r / 64, nb = r % 64, k0 = 64 * kb, n0 = 32 * nb; src = w_out + (size_t)k0 * DM + n0; ldw = DM; dst = WOUTT + (size_t)n0 * DM + k0; }
    };
    constexpr int NIT = NITEMS * (PROBE_REPEAT == 0 ? 2 : 1);
    const int gwi = (gw + NGW - (M % NGW)) % NGW;
    if (gwi < NIT) {
        f32x4 va[8], vb[8]; const float* src; int ldw; bf16* dst; bf16* dstn = nullptr;
        item_addr(gwi, src, ldw, dst); p0_item_load(va, src, ldw, F.lane);
        for (int it = gwi; it < NIT; it += 2 * NGW) {
            const bool h1 = it + NGW < NIT;
            if (h1) { item_addr(it + NGW, src, ldw, dstn); p0_item_load(vb, src, ldw, F.lane); }
            p0_item_finish(va, dst, DM, scr, F.lane);
            if (!h1) break;
            const bool h2 = it + 2 * NGW < NIT;
            if (h2) { item_addr(it + 2 * NGW, src, ldw, dst); p0_item_load(va, src, ldw, F.lane); }
            p0_item_finish(vb, dstn, DM, scr, F.lane);
            if (!h2) break;
        }
    }
}
__device__ __forceinline__ void cumsum_bh(Frame& F, const float* LF, float* CS2, int* T0TAB, int bh, float fox_thr) {
    const float* src = LF + (size_t)bh * SEQ + F.tid * 8; float* dst = CS2 + (size_t)bh * SEQ + F.tid * 8;
    const f32x4 a = *(const f32x4*)src, b = *(const f32x4*)(src + 4);
    float v[8]; v[0] = a.x; v[1] = v[0] + a.y; v[2] = v[1] + a.z; v[3] = v[2] + a.w; v[4] = v[3] + b.x; v[5] = v[4] + b.y; v[6] = v[5] + b.z; v[7] = v[6] + b.w;
    float incl = v[7];
#pragma unroll
    for (int o = 1; o < 64; o <<= 1) { const float t = __shfl_up(incl, o); if (F.lane >= o) incl += t; }
    if (F.lane == 63) F.MISC[16 + F.wave] = __builtin_bit_cast(unsigned, incl);
    __syncthreads();
    float off = incl - v[7];
    for (int w = 0; w < F.wave; ++w) off += __builtin_bit_cast(float, (unsigned)F.MISC[16 + w]);
    f32x4 o0, o1; o0.x = (v[0] + off) * LOG2E; o0.y = (v[1] + off) * LOG2E; o0.z = (v[2] + off) * LOG2E; o0.w = (v[3] + off) * LOG2E;
    o1.x = (v[4] + off) * LOG2E; o1.y = (v[5] + off) * LOG2E; o1.z = (v[6] + off) * LOG2E; o1.w = (v[7] + off) * LOG2E;
    *(f32x4*)dst = o0; *(f32x4*)(dst + 4) = o1;
    LAS float* csl = (LAS float*)(F.lds + RING_OFF);
    *(LAS f32x4*)(csl + F.tid * 8) = o0; *(LAS f32x4*)(csl + F.tid * 8 + 4) = o1;
    __syncthreads();
    if (F.tid < 16) { const int qb = F.tid, nb = 4 * qb; const float cq0 = csl[256 * qb]; int lo = 0, hi = nb;
        while (lo < hi) { const int mid = (lo + hi) >> 1; if (cq0 - csl[64 * mid + 63] >= -fox_thr) hi = mid; else lo = mid + 1; }
        T0TAB[bh * 16 + qb] = lo; }
    __syncthreads();
}

constexpr int N_PHASES = 5;
__global__ void __launch_bounds__(NWAVES * 64, 2) mega_fwd(Args args) {
    extern __shared__ __attribute__((aligned(16))) unsigned char lds[];
    Frame F;
    F.lds = (LAS unsigned char*)lds;
    F.MISC = (volatile LAS unsigned*)(F.lds + MISC_OFF);
    F.tid = threadIdx.x; F.lane = F.tid & 63; F.wave = __builtin_amdgcn_readfirstlane(F.tid >> 6);
    F.G = gridDim.x; { const int bx = blockIdx.x; F.vcu = (F.G % 8 == 0) ? (bx % 8) * (F.G / 8) + bx / 8 : bx; }
    unsigned char* ws = args.ws;
    F.ctl = (gu32*)(ws + WS_CTL);
    for (int u = F.tid; u < (LDS_BYTES - LDSCTL_OFF) / 4; u += NWAVES * 64) ((LAS unsigned*)(F.lds + LDSCTL_OFF))[u] = 0u;
    __syncthreads();
    const int lo = args.ph_lo, hi = args.ph_hi;
    XcdBarrier bar; bar.bar = (unsigned*)(F.ctl + CW_BAR) + args.li * XCD_BAR_WORDS; bar.x = 0; bar.st = nullptr;
    if (hi - lo > 1) bar = xcd_barrier_post((unsigned*)(F.ctl + CW_BAR) + args.li * XCD_BAR_WORDS, F.MISC + 8);
#define IN(k) (lo <= (k) && (k) < hi)
#define BOTH(k) (IN(k) && IN((k) + 1))
#define GRID_BAR() do { xcd_barrier(bar); if (PROBE_REPEAT == 6) { xcd_barrier(bar); xcd_barrier(bar); } } while (0)
    bf16* HN = (bf16*)(ws + WS_HN); bf16* MEMN = (bf16*)(ws + WS_MEMN); bf16* MKV = (bf16*)(ws + WS_MKV); bf16* PG = (bf16*)(ws + WS_PG); bf16* U = (bf16*)(ws + WS_U); bf16* Y = (bf16*)(ws + WS_Y);
    bf16* QA = (bf16*)(ws + WS_QA); bf16* ZA = (bf16*)(ws + WS_ZA); bf16* QB = (bf16*)(ws + WS_QB); bf16* ZB = (bf16*)(ws + WS_ZB); bf16* KB = (bf16*)(ws + WS_KB); bf16* VB = (bf16*)(ws + WS_VB); bf16* KA = (bf16*)(ws + WS_KA); bf16* VA = (bf16*)(ws + WS_VA);
    bf16* W1T = (bf16*)(ws + WS_W1T); bf16* WMKVT = (bf16*)(ws + WS_WMKVT); bf16* WBRT = (bf16*)(ws + WS_WBRT); bf16* WOUTT = (bf16*)(ws + WS_WOUTT);
    float* CS2 = (float*)(ws + WS_CS2); float* LF = (float*)(ws + WS_LF); int* T0TAB = (int*)(ws + WS_T0);

    if (IN(0)) { p0_prologue(F, args); if (BOTH(0)) GRID_BAR(); }

    if (IN(1)) {
        if ((int)blockIdx.x < BATCH * 12) {
            float gq = fabsf(args.in[9][F.lane]), gk = fabsf(args.in[10][F.lane]);
#pragma unroll
            for (int o = 1; o < 64; o <<= 1) { gq = fmaxf(gq, __shfl_xor(gq, o)); gk = fmaxf(gk, __shfl_xor(gk, o)); }
            cumsum_bh(F, LF, CS2, T0TAB, (int)blockIdx.x, 2.f * (64.f * C2_64 * gq * gk * 1.02f) + 40.f); }
        { pg8::Gemm g{HN, W1T, M, NP, DM}; pg8::StaticOrder S; S.init(M, NP, F.G, (int)blockIdx.x); S.rep = (PROBE_REPEAT == 1) ? 2 : 1; S.wgm = P1_WGM;
          pg8::EpiProj E{PG, QA, ZA, QB, ZB, KB, VB, KA, VA, args.in[6], args.in[7], args.in[9], args.in[10], C2_64, EPS, GATE_MIN};
          pg8::gemm_phase<pg8::EpiProj, pg8::StaticOrder, P1_ALIGN, P1_SP2>(F.lds + RING_OFF, g, S, E);
#if PROBE_REPEAT == 21
          { pg8::EpiPlain E2{(bf16*)(ws + WS_END + 2 * MiB), DM};
            pg8::gemm_phase<pg8::EpiPlain, pg8::StaticOrder, P1_ALIGN, P1_SP2>(F.lds + RING_OFF, g, S, E2); }
#endif
        }
        if (BOTH(1)) GRID_BAR();
    }
    if (IN(2)) {
        gu32* mkf = F.ctl + CW_MKF;
        LAS int* t0l = (LAS int*)(F.lds + T0L_OFF);
        for (int i2 = F.tid; i2 < 384; i2 += NWAVES * 64) t0l[i2] = T0TAB[i2];
        if (F.tid < 12) ((LAS float*)t0l)[1160 + F.tid] = args.in[8][F.tid];
#if PROBE_REPEAT == 50 || PROBE_REPEAT == 67
#ifndef PROBE_FORCE_NT
#define PROBE_FORCE_NT 0
#endif
        if (F.tid == 0) t0l[1152] = args.pad ? PROBE_FORCE_NT : 0;
#endif
        __syncthreads();
        if (LPT_SORT) {
            if (F.tid < 384) { const int bh = F.tid % 24, qb = 15 - F.tid / 24; t0l[768 + F.tid] = qb * 4 + 4 - t0l[bh * 16 + qb]; }
            __syncthreads();
            if (F.tid < 384) { const int my = t0l[768 + F.tid]; int rank = 0;
                for (int j = 0; j < 384; j += 4) { typedef int i32x4_ __attribute__((ext_vector_type(4))); const i32x4_ v = *(const LAS i32x4_*)(t0l + 768 + j);
                    rank += (v.x > my || (v.x == my && j < F.tid)) + (v.y > my || (v.y == my && j + 1 < F.tid)) + (v.z > my || (v.z == my && j + 2 < F.tid)) + (v.w > my || (v.w == my && j + 3 < F.tid)); }
                t0l[384 + rank] = F.tid; }
        }
        constexpr int n_total = att::N_UNITS * (PROBE_REPEAT == 2 ? 2 : 1) + (PROBE_REPEAT == 7 ? 384 : 0) + (PROBE_REPEAT == 8 ? 384 : 0) + (PROBE_REPEAT == 11 ? 128 : 0) + ((PROBE_REPEAT == 12 || PROBE_REPEAT == 13 || PROBE_REPEAT == 14 || (PROBE_REPEAT >= 40 && PROBE_REPEAT < 50)) ? 384 : 0);
#if PROBE_REPEAT >= 50 && PROBE_REPEAT < 70
        const unsigned q_lo = (unsigned)args.pad & 0xffffu; const int n_tot_rt = (args.pad >> 16) ? (args.pad >> 16) : n_total;
#define n_total n_tot_rt
#define P2_WINDOW 1
#else
        const unsigned q_lo = STATIC_FIRST ? (unsigned)F.G : 0u;
#endif
        att::Tensors T{ws, args.in[8], args.in[11], args.in[12], (const LAS int*)t0l, (const unsigned*)mkf, args.pad, (unsigned*)(F.ctl + CW_Q), q_lo};
#if defined(P2_WINDOW) || !STATIC_FIRST
        if (F.tid == 0) { const unsigned q = __hip_atomic_fetch_add((unsigned*)(F.ctl + CW_Q), 1u, __ATOMIC_RELAXED, __HIP_MEMORY_SCOPE_AGENT) + q_lo;
            F.MISC[24] = q; }
        __syncthreads();
        int cu = __builtin_amdgcn_readfirstlane((int)F.MISC[24]);
#else
        int cu = (int)blockIdx.x;
#endif
        if (cu < n_total) {
            att::Desc cur = att::decode(PROBE_MAP(cu), T.t0tab);
            { const att::Geo g0 = att::geo(T, cur); att::issue_head(T, g0, cur, (unsigned)(size_t)(F.lds + RING_OFF), F.wave, F.lane); att::issue_rest(g0, cur, (unsigned)(size_t)(F.lds + RING_OFF), F.wave, F.lane); }
            for (;;) {
                const unsigned nidx = 0u;
                int nu; att::Desc nd = cur;
#if PROBE_REPEAT >= 40 && PROBE_REPEAT < 50
                if (cur.kind == 1 && cur.dummy) att::unit<1, PROBE_REPEAT>(T, cur, F.lds + RING_OFF, F.MISC, nidx, n_total, nu, nd); else
#endif
                if (cur.kind == 1) att::unit<1>(T, cur, F.lds + RING_OFF, F.MISC, nidx, n_total, nu, nd);
                else if (cur.kind == 2) att::unit<2>(T, cur, F.lds + RING_OFF, F.MISC, nidx, n_total, nu, nd);
                else att::unit<0>(T, cur, F.lds + RING_OFF, F.MISC, nidx, n_total, nu, nd);
                if (nu >= n_total) break;
                cur = nd;
            }
        }
        VM_WAIT();
#if PROBE_REPEAT >= 50 && PROBE_REPEAT < 70
#undef n_total
#endif
        if (BOTH(2)) GRID_BAR();
    }
    if (IN(3)) {
        pg8::Gemm g{U, WBRT, M, DM, DM}; pg8::StaticOrder S; S.init(M, DM, F.G, (int)blockIdx.x); S.rep = (PROBE_REPEAT == 3) ? 2 : 1;
        pg8::EpiGate E{PG + (size_t)M * PGW, Y, DM};
        pg8::gemm_phase<pg8::EpiGate, pg8::StaticOrder, true, true>(F.lds + RING_OFF, g, S, E);
#if PROBE_REPEAT == 23
        { pg8::EpiPlain E2{(bf16*)(ws + WS_END + 2 * MiB), DM}; pg8::gemm_phase<pg8::EpiPlain, pg8::StaticOrder, true, true>(F.lds + RING_OFF, g, S, E2); }
#endif
        if (BOTH(3)) GRID_BAR();
    }
    if (IN(4)) {
        pg8::Gemm g{Y, WOUTT, M, DM, DM}; pg8::StaticOrder S; S.init(M, DM, F.G, (int)blockIdx.x); S.rep = (PROBE_REPEAT == 4) ? 2 : 1;
        pg8::EpiOut E{args.in[0], args.out, DM};
        pg8::gemm_phase<pg8::EpiOut, pg8::StaticOrder, true, true>(F.lds + RING_OFF, g, S, E);
    }
#undef IN
#undef BOTH
#undef GRID_BAR
}

static int launch_mega(Args a, int lo, int hi, int li, int grid, hipStream_t stream, int pad = 0) {
    a.ph_lo = lo; a.ph_hi = hi; a.li = li; a.pad = pad;
    hipLaunchKernelGGL(mega_fwd, dim3(grid), dim3(NWAVES * 64), LDS_BYTES, stream, a);
    const hipError_t le = hipPeekAtLastError();
    if (le != hipSuccess) { fprintf(stderr, "kernel_launch: launch [%d,%d) failed: %s\n", lo, hi, hipGetErrorName(le)); return -1; }
    return 0;
}
extern "C" void kernel_launch(void* const* d_in, const int* in_sizes, int n_in, void* d_out, int out_size, void* d_ws, size_t ws_size, hipStream_t stream) {
    static int grid = 0;
    if (grid == 0) {
        if (n_in != 18 || in_sizes[0] != M * DM || out_size != M * DM || ws_size < WS_END) { fprintf(stderr, "kernel_launch: unexpected shapes (n_in %d, in0 %d, out %d, ws %zu)\n", n_in, n_in > 0 ? in_sizes[0] : -1, out_size, ws_size); grid = -1; return; }
        int dev = 0, cus = 0, per_cu = 0;
        if (hipGetDevice(&dev) != hipSuccess || hipDeviceGetAttribute(&cus, hipDeviceAttributeMultiprocessorCount, dev) != hipSuccess) { fprintf(stderr, "kernel_launch: device query failed\n"); grid = -1; return; }
        if (hipFuncSetAttribute((const void*)mega_fwd, hipFuncAttributeMaxDynamicSharedMemorySize, LDS_BYTES) != hipSuccess) { fprintf(stderr, "kernel_launch: hipFuncSetAttribute failed\n"); grid = -1; return; }
        if (hipOccupancyMaxActiveBlocksPerMultiprocessor(&per_cu, (const void*)mega_fwd, NWAVES * 64, LDS_BYTES) != hipSuccess || per_cu < 1) { fprintf(stderr, "kernel_launch: occupancy query reports %d workgroups per CU; not launching\n", per_cu); (void)hipGetLastError(); grid = -1; return; }
        grid = cus;
        if (grid < 64) { fprintf(stderr, "kernel_launch: %d compute units: this phase program expects a full MI355X (eight producer workgroups beside the others)\n", grid); grid = -1; return; }
    }
    if (grid < 0) return;
    if (hipMemsetAsync((char*)d_ws + WS_CTL, 0, CTL_ZERO_BYTES, stream) != hipSuccess) { fprintf(stderr, "kernel_launch: memset failed\n"); return; }
    Args a{};
    for (int i = 0; i < 18; ++i) a.in[i] = (const float*)d_in[i];
    a.out = (float*)d_out; a.ws = (unsigned char*)d_ws;
    unsigned char* ws = (unsigned char*)d_ws;
    bf16* MKV = (bf16*)(ws + WS_MKV); bf16* PG = (bf16*)(ws + WS_PG); bf16* U = (bf16*)(ws + WS_U); bf16* Y = (bf16*)(ws + WS_Y);
    bf16* QA = (bf16*)(ws + WS_QA); bf16* ZA = (bf16*)(ws + WS_ZA); bf16* QB = (bf16*)(ws + WS_QB); bf16* ZB = (bf16*)(ws + WS_ZB); bf16* KB = (bf16*)(ws + WS_KB); bf16* VB = (bf16*)(ws + WS_VB); bf16* KA = (bf16*)(ws + WS_KA); bf16* VA = (bf16*)(ws + WS_VA); float* CS2 = (float*)(ws + WS_CS2);
    const float* sinks_a = (const float*)d_in[8]; const float* q_gain_c = (const float*)d_in[11]; const float* k_gain_c = (const float*)d_in[12];
#if PROBE_REPEAT >= 35 && PROBE_REPEAT <= 38
    if (launch_mega(a, 0, PROBE_REPEAT - 34, 0, grid, stream)) return;
    if (hipMemsetAsync((char*)d_ws + WS_CTL, 0, CTL_ZERO_BYTES, stream) != hipSuccess) return;
#endif
    if (launch_mega(a, 0, N_PHASES, 0, grid, stream)) return;
#if PROBE_REPEAT >= 30 && PROBE_REPEAT <= 34
    if (hipMemsetAsync((char*)d_ws + WS_CTL, 0, CTL_ZERO_BYTES, stream) != hipSuccess) return;
    if (launch_mega(a, 0, PROBE_REPEAT - 30, 0, grid, stream)) return;
#endif
#if PROBE_REPEAT >= 50 && PROBE_REPEAT < 70
    if (hipMemsetAsync((char*)d_ws + WS_CTL, 0, CTL_ZERO_BYTES, stream) != hipSuccess) return;
    if (launch_mega(a, 0, 3, 0, grid, stream, PROBE_REPEAT == 50 ? ((PROBE_WIN_HI << 16) | PROBE_WIN_LO) : PROBE_REPEAT == 51 ? (384 << 16) : PROBE_REPEAT == 52 ? ((896 << 16) | 384) : PROBE_REPEAT == 58 ? (256 << 16) : PROBE_REPEAT == 59 ? ((384 << 16) | 256) : PROBE_REPEAT == 67 ? (1024 << 16) : PROBE_REPEAT >= 60 ? ((1408 << 16) | 384) : (PROBE_REPEAT == 53 || (PROBE_REPEAT >= 55 && PROBE_REPEAT < 58)) ? ((576 << 16) | 384) : PROBE_REPEAT == 54 ? ((704 << 16) | 576) : 0)) return;
#endif
#if PROBE_REPEAT >= 71 && PROBE_REPEAT <= 76
    if (hipMemsetAsync((char*)d_ws + WS_CTL, 0, CTL_ZERO_BYTES, stream) != hipSuccess) return;
    if (launch_mega(a, 0, 1, 0, grid, stream, 1)) return;
#endif
#if PROBE_REPEAT == 81
    for (int rep = 0; rep < 4; ++rep) {
        if (hipMemsetAsync((char*)d_ws + WS_CTL, 0, CTL_ZERO_BYTES, stream) != hipSuccess) return;
        if (launch_mega(a, 0, 1, 0, grid, stream, 1)) return; }
#endif
#if PROBE_REPEAT == 80
    for (int rep = 0; rep < 4; ++rep) {
        if (hipMemsetAsync((char*)d_ws + WS_CTL, 0, CTL_ZERO_BYTES, stream) != hipSuccess) return;
        if (launch_mega(a, 2, 3, 0, grid, stream, 0)) return; }
#endif
#if PROBE_REPEAT == 20
    if (hipMemsetAsync((char*)d_ws + WS_CTL, 0, CTL_ZERO_BYTES, stream) != hipSuccess) return;
    if (launch_mega(a, 0, N_PHASES, 0, grid, stream)) return;
#endif
}
```

```cpp
#include <hip/hip_runtime.h>
#include <cstdint>
#include <cstdio>

constexpr int BATCH = 2, SEQ = 4096, DM = 2048, M = BATCH * SEQ;
constexpr int MEMT = 256, MM = BATCH * MEMT;
constexpr int IN_W = 12300;
constexpr int NP = 12288;
constexpr int PC_QA = 0, PC_KA = 768, PC_VA = 1024, PC_ZA = 1280, PC_QB = 2048, PC_KB = 2816, PC_VB = 3584, PC_ZB = 4352, PC_QC = 5120, PC_ZC = 5632, PC_G = 6144;
constexpr int PGW = 1024, PG_QC = 0, PG_ZC = 512;
constexpr int SRC_FB = 5120;
constexpr float LOG2E = 1.4426950408889634f;
constexpr float C2_64 = 0.125f * LOG2E;
constexpr float C2_128 = 0.08838834764831845f * LOG2E;
constexpr float EPS = 1e-6f;
constexpr float GATE_MIN = 1e-18f;

constexpr size_t MiB = 1u << 20;
constexpr size_t WS_CTL = 0, CTL_ZERO_BYTES = 1 * MiB, WS_CS2 = 1 * MiB, WS_LF = 1 * MiB + 512 * 1024, WS_MEMN = 2 * MiB, WS_MKV = 4 * MiB, WS_WMKVT = 6 * MiB, WS_WBRT = 10 * MiB, WS_WOUTT = 18 * MiB,
                 WS_HN = 26 * MiB, WS_W1T = 58 * MiB, WS_P = 106 * MiB, WS_END = 298 * MiB;
constexpr size_t WS_WFB = WS_CS2 + 393216;
constexpr size_t WS_T0 = WS_LF + 393216;
constexpr size_t WS_PG = WS_P, WS_QA = WS_P + 112 * MiB, WS_ZA = WS_QA + 12 * MiB, WS_QB = WS_ZA + 12 * MiB, WS_ZB = WS_QB + 12 * MiB, WS_KB = WS_ZB + 12 * MiB, WS_VB = WS_KB + 12 * MiB, WS_KA = WS_VB + 12 * MiB, WS_VA = WS_KA + 4 * MiB;
static_assert(WS_VA + 4 * MiB == WS_END, "ws map");
constexpr size_t WS_Y = WS_HN;
constexpr size_t WS_U = WS_W1T;

typedef unsigned short bf16;
__device__ __forceinline__ unsigned f2bf(float f) { unsigned u = __builtin_bit_cast(unsigned, f); return (u + 0x7fffu + ((u >> 16) & 1u)) >> 16; }
__device__ __forceinline__ float bf2f(unsigned short h) { return __builtin_bit_cast(float, (unsigned)h << 16); }
__device__ __forceinline__ unsigned pk2(float lo, float hi) { typedef float f2_ __attribute__((ext_vector_type(2))); typedef __bf16 b2_ __attribute__((ext_vector_type(2))); f2_ v = {lo, hi}; b2_ b = __builtin_convertvector(v, b2_); return __builtin_bit_cast(unsigned, b); }
__device__ __forceinline__ float wave_sum(float v) {
#pragma unroll
    for (int o = 1; o < 64; o <<= 1) v += __shfl_xor(v, o);
    return v;
}
__device__ __forceinline__ float sigmoidf_(float x) { return 1.f / (1.f + __expf(-x)); }
__device__ __forceinline__ float log_sigmoidf_(float x) { return fminf(x, 0.f) - log1pf(__expf(-fabsf(x))); }
__device__ __forceinline__ float fast_sigmoid(float v) { return __builtin_amdgcn_rcpf(1.f + __builtin_amdgcn_exp2f(-LOG2E * v)); }

#ifndef P3_ROT
#define P3_ROT 0
#endif
namespace pg8 {
#define PG8_LAS __attribute__((address_space(3)))
typedef unsigned short bf16_t;
typedef short bf16x8 __attribute__((ext_vector_type(8)));
typedef float f32x4 __attribute__((ext_vector_type(4)));
typedef unsigned u32x4 __attribute__((ext_vector_type(4)));
constexpr int BM = 256, BK = 64, HALF = 128, HTB = HALF * BK * 2  , STAGE_BYTES = 8 * HTB, NXCD = 8, WGM = 8;

__host__ __device__ __forceinline__ int lds_byte(int r, int c) { const int st = (r >> 4) * 2 + (c >> 5), rr = r & 15, cc = c & 31, ob = rr * 64 + cc * 2; return st * 1024 + (ob ^ (((ob >> 9) & 1) << 5)); }
__host__ __device__ __forceinline__ void stage_rc(int b, int& R, int& C) { const int st = b / 1024, sb = b % 1024, swz = sb ^ (((sb >> 9) & 1) << 5); R = (st >> 1) * 16 + swz / 64; C = (st & 1) * 32 + (swz % 64) / 2; }
__host__ __device__ __forceinline__ int perm32(int rho) { const int n = rho >> 4, i = rho & 15; return 8 * (i >> 2) + 4 * n + (i & 3); }

struct Unit { int pm, pn, rot; };
struct Gemm { const bf16_t* A; const bf16_t* Bt; int M, N, K; };

struct StaticOrder {
    int nM, nN, nwg, G, c, rep, wgm, mix;
    __host__ __device__ void init(int M, int N, int G_, int c_) { nM = M / BM; nN = N / BM; nwg = nM * nN; G = G_; c = c_; rep = 1; wgm = WGM; mix = 0; }
    __host__ __device__ bool next(int i, Unit& u) const {
        const int rounds = (nwg + G - 1) / G; if (i >= rounds * rep) return false; i = i % rounds;
        const long L = (long)i * G + c; if (L >= nwg) return false;
        int wgid = (int)L; { const int q = nwg / NXCD, r = nwg % NXCD, xcd = wgid % NXCD, off = wgid / NXCD; wgid = (xcd < r ? xcd * (q + 1) : r * (q + 1) + (xcd - r) * q) + off; }
        const int nig = wgm * nN, gid = wgid / nig, fm = gid * wgm, gsz = (nM - fm) < wgm ? (nM - fm) : wgm;
        u.pm = fm + ((wgid % nig) % gsz); u.pn = (wgid % nig) / gsz; if (mix) { const int jj = u.pn ^ ((mix > 1) ? (i & 1) : 0); u.pn = (jj & 1) * (nN / 2) + (jj >> 1); }
        u.rot = 0; return true;
    }
    __device__ __forceinline__ void a_ready(const Unit&) const {}
    __device__ __forceinline__ void done(const Unit&) const {}
};

struct SingleOrder { int pm, pn;
    __device__ __forceinline__ bool next(int i, Unit& u) const { if (i != 0) return false; u.pm = pm; u.pn = pn; u.rot = 0; return true; }
    __device__ __forceinline__ void a_ready(const Unit&) const {}
    __device__ __forceinline__ void done(const Unit&) const {}
};
__device__ __forceinline__ unsigned cvt_pk_bf16(float lo, float hi) { unsigned r; asm volatile("v_cvt_pk_bf16_f32 %0, %1, %2" : "=v"(r) : "v"(lo), "v"(hi)); return r; }
typedef float f32x2 __attribute__((ext_vector_type(2)));
#ifndef GATE_NT
#define GATE_NT 1
#endif
#ifndef P1_NT
#define P1_NT 0
#endif

__device__ __forceinline__ f32x4 bf4_lo(unsigned a, unsigned b) { return (f32x4){__builtin_bit_cast(float, a << 16), __builtin_bit_cast(float, a & 0xffff0000u), __builtin_bit_cast(float, b << 16), __builtin_bit_cast(float, b & 0xffff0000u)}; }
__device__ __forceinline__ u32x4 pack8(const f32x4 v0, const f32x4 v1) { u32x4 w; w.x = cvt_pk_bf16(v0[0], v0[1]); w.y = cvt_pk_bf16(v0[2], v0[3]); w.z = cvt_pk_bf16(v1[0], v1[1]); w.w = cvt_pk_bf16(v1[2], v1[3]); return w; }
__device__ __forceinline__ float sigm(float v) { return __builtin_amdgcn_rcpf(1.f + __builtin_amdgcn_exp2f(-1.4426950408889634f * v)); }

struct EpiProj {
    static constexpr bool PERM = true, AFTER_DRAIN = false, HEADPERM = true, MIDHOOK = false;
    bf16_t* PG; bf16_t* QA; bf16_t* ZA; bf16_t* QB; bf16_t* ZB; bf16_t* KB; bf16_t* VB; bf16_t* KA; bf16_t* VA;
    const float* g_qa; const float* g_ka; const float* g_qb; const float* g_kb; float qscale; float eps; float gate_min;
    static constexpr int G_OFF = 8192 * 1024;
    __device__ __forceinline__ void operator()(const f32x4 (&acc)[2][2][4][2], const Unit& u, int wr, int wc, int fr, int fq) const {
        const int pn = u.pn; int mode = 0; const float* gain = g_qa; float sc = 1.f;
        int lay = 0; bf16_t* dst = PG; int head = 0, nh = 12, pgcol = 0;
        if (pn < 3) { mode = 3; gain = g_qa; sc = qscale; lay = 1; dst = QA; head = pn * 4 + wc; } else if (pn < 4) { mode = 3; gain = g_ka; lay = 2; dst = KA; head = wc; nh = 4; }
        else if (pn < 5) { mode = 0; lay = 3; dst = VA; head = wc; nh = 4; } else if (pn < 8) { mode = 1; lay = 1; dst = ZA; head = (pn - 5) * 4 + wc; }
        else if (pn < 11) { mode = 3; gain = g_qb; sc = qscale; lay = 1; dst = QB; head = (pn - 8) * 4 + wc; } else if (pn < 14) { mode = 3; gain = g_kb; lay = 2; dst = KB; head = (pn - 11) * 4 + wc; }
        else if (pn < 17) { mode = 0; lay = 3; dst = VB; head = (pn - 14) * 4 + wc; } else if (pn < 20) { mode = 1; lay = 1; dst = ZB; head = (pn - 17) * 4 + wc; }
        else if (pn < 22) { mode = 0; pgcol = (pn - 20) * BM; } else if (pn < 24) { mode = 1; pgcol = 512 + (pn - 22) * BM; } else { mode = 2; lay = 4; }
        const int row0 = u.pm * BM + wr * 64 + fr;
        f32x4 gv[2][2];
#pragma unroll
        for (int bj = 0; bj < 2; ++bj)
#pragma unroll
            for (int n = 0; n < 2; ++n) gv[bj][n] = (mode == 3) ? *(const f32x4*)(gain + 32 * bj + 8 * fq + 4 * n) : (f32x4){1.f, 1.f, 1.f, 1.f};
#pragma unroll
        for (int ai = 0; ai < 2; ++ai)
#pragma unroll
            for (int m = 0; m < 4; ++m) { const int row = row0 + ai * HALF + m * 16, b = row >> 12, t = row & 4095;
                size_t o0, o1;
                if (lay == 4) {
                    const int gi = (pn - 24) >> 3, ct = (pn - 24) & 7;
                    o0 = (size_t)G_OFF + ((((size_t)(u.pm * 8 + ct) * 3 + gi) * 8 + (wr * 4 + wc)) * 16 + (ai * 8 + m * 2)) * 512 + (size_t)(fq * 16 + fr) * 8; o1 = o0 + 512; }
                else if (lay == 0) { o0 = (size_t)row * 1024 + pgcol + wc * 64 + 8 * fq; o1 = o0 + 32; }
                else if (lay == 1) { o0 = ((size_t)(b * 12 + head) * 4096 + t) * 64 + 8 * fq; o1 = o0 + 32; }
                else if (lay == 2) { o0 = ((size_t)(b * nh + head) * 64 + (t >> 6)) * 4096 + fq * 512 + (t & 63) * 8; o1 = o0 + 4 * 512; }
                else { o0 = ((size_t)(b * nh + head) * 64 + (t >> 6)) * 4096 + (t & 63) * 32 + fq * 8; o1 = o0 + 2048; }
                float rs = 1.f;
                if (mode == 3) { float s = 0.f;
#pragma unroll
                    for (int bj = 0; bj < 2; ++bj)
#pragma unroll
                        for (int n = 0; n < 2; ++n) { const f32x4 x = acc[ai][bj][m][n]; s += (x[0] * x[0] + x[1] * x[1]) + (x[2] * x[2] + x[3] * x[3]); }
                    s += __shfl_xor(s, 16); s += __shfl_xor(s, 32);
                    rs = sc * __builtin_amdgcn_rsqf(s * (1.f / 64.f) + eps); }
#pragma unroll
                for (int bj = 0; bj < 2; ++bj) { f32x4 v0 = acc[ai][bj][m][0], v1 = acc[ai][bj][m][1];
                    if (mode == 3) { v0 = v0 * rs * gv[bj][0]; v1 = v1 * rs * gv[bj][1]; }
                    else if (mode == 1) {
#pragma unroll
                        for (int j = 0; j < 4; ++j) { v0[j] = v0[j] * sigm(v0[j]); v1[j] = v1[j] * sigm(v1[j]); } }
                    else if (mode == 2) {
#pragma unroll
                        for (int j = 0; j < 4; ++j) { v0[j] = __builtin_fmaxf(sigm(v0[j]), gate_min); v1[j] = __builtin_fmaxf(sigm(v1[j]), gate_min); } }
                    if (P1_NT) __builtin_nontemporal_store(pack8(v0, v1), (u32x4*)(dst + (bj == 0 ? o0 : o1))); else *(u32x4*)(dst + (bj == 0 ? o0 : o1)) = pack8(v0, v1); } }
    }
};
struct EpiPlain {
    static constexpr bool PERM = true, AFTER_DRAIN = false, HEADPERM = true, MIDHOOK = false;
    bf16_t* O; int ldc;
    __device__ __forceinline__ void operator()(const f32x4 (&acc)[2][2][4][2], const Unit& u, int wr, int wc, int fr, int fq) const {
        const int row0 = u.pm * BM + wr * 64 + fr, col0 = u.pn * BM + wc * 64 + 8 * fq;
#pragma unroll
        for (int ai = 0; ai < 2; ++ai)
#pragma unroll
            for (int m = 0; m < 4; ++m) { bf16_t* rowp = O + (size_t)(row0 + ai * HALF + m * 16) * ldc + col0;
#pragma unroll
                for (int bj = 0; bj < 2; ++bj) *(u32x4*)(rowp + bj * 32) = pack8(acc[ai][bj][m][0], acc[ai][bj][m][1]); }
    }
};
struct EpiMkv {
    static constexpr bool PERM = true, AFTER_DRAIN = true, HEADPERM = true, MIDHOOK = false;
    bf16_t* KI; bf16_t* VI; const float* g_kc; float eps;
    __device__ __forceinline__ void fused(f32x4 (&acc)[2][2][4][2], const Unit& u, int wr, int wc, int fr, int fq, PG8_LAS unsigned char* lds, int wid, int lane) const {
        const int head = (u.pn & 1) * 2 + (wc >> 1), sub = wc & 1; const bool isK = u.pn < 2;
        PG8_LAS float* Pq = (PG8_LAS float*)lds;
        if (isK) {
#pragma unroll
            for (int ai = 0; ai < 2; ++ai)
#pragma unroll
                for (int m = 0; m < 4; ++m) { float sq = 0.f;
#pragma unroll
                    for (int bj = 0; bj < 2; ++bj)
#pragma unroll
                        for (int n = 0; n < 2; ++n) { const f32x4 x = acc[ai][bj][m][n]; sq += (x[0] * x[0] + x[1] * x[1]) + (x[2] * x[2] + x[3] * x[3]); }
                    sq += __shfl_xor(sq, 16); sq += __shfl_xor(sq, 32);
                    if (fq == 0) Pq[(ai * HALF + wr * 64 + m * 16 + fr) * 4 + wc] = sq; }
        }
        asm volatile("s_waitcnt lgkmcnt(0)" ::: "memory"); __builtin_amdgcn_s_barrier(); asm volatile("" ::: "memory");
        f32x4 gv[2][2];
#pragma unroll
        for (int bj = 0; bj < 2; ++bj)
#pragma unroll
            for (int n = 0; n < 2; ++n) gv[bj][n] = isK ? *(const f32x4*)(g_kc + sub * 64 + 32 * bj + 8 * fq + 4 * n) : (f32x4){1.f, 1.f, 1.f, 1.f};
#pragma unroll
        for (int ai = 0; ai < 2; ++ai)
#pragma unroll
            for (int m = 0; m < 4; ++m) { const int t = ai * HALF + wr * 64 + m * 16 + fr, tile = t >> 6, r = t & 63;
                float rs = 1.f; if (isK) { const float tot = Pq[t * 4 + wc] + Pq[t * 4 + (wc ^ 1)]; rs = __builtin_amdgcn_rsqf(tot * (1.f / 128.f) + eps); }
                const size_t tb = ((size_t)(u.pm * 4 + head) * 4 + tile) * 8192;
#pragma unroll
                for (int bj = 0; bj < 2; ++bj) { const f32x4 v0 = acc[ai][bj][m][0] * rs * gv[bj][0], v1 = acc[ai][bj][m][1] * rs * gv[bj][1];
                    if (isK) *(u32x4*)(KI + tb + (size_t)(sub * 8 + 4 * bj + fq) * 512 + r * 8) = pack8(v0, v1);
                    else *(u32x4*)(VI + tb + (size_t)(sub * 2 + bj) * 2048 + r * 32 + fq * 8) = pack8(v0, v1); } }
    }
};
struct EpiGate {
    static constexpr bool PERM = true, AFTER_DRAIN = false, HEADPERM = true, MIDHOOK = true;
    const bf16_t* G; bf16_t* Y; int ldc;
    __device__ __forceinline__ void mid(f32x4 (&acc)[2][2][4][2], const Unit& u, int wr, int wc, int fr, int fq, int from) const {
        const int gnum = from; const ptrdiff_t dgate = (from == 2) ? -(ptrdiff_t)(2 * 8 * 8192) : (ptrdiff_t)(8 * 8192);
        typedef const __attribute__((address_space(1))) bf16_t* gptr_t; typedef const __attribute__((address_space(1))) u32x4* gq_t;
        gptr_t gbase = (gptr_t)(G + ((size_t)((u.pm * 8 + u.pn) * 3 + gnum) * 8 + (wr * 4 + wc)) * 8192 + (fq * 16 + fr) * 8); asm volatile("" : "+v"(gbase));
#pragma unroll
        for (int ai = 0; ai < 2; ++ai)
#pragma unroll
            for (int m = 0; m < 4; ++m)
#pragma unroll
                for (int bj = 0; bj < 2; ++bj) { gptr_t gp = gbase + (ai * 8 + m * 2 + bj) * 512; const u32x4 a = GATE_NT ? __builtin_nontemporal_load((gq_t)gp) : *(gq_t)gp, b = *(gq_t)(gp + dgate);
                    f32x4 n0 = bf4_lo(a.x, a.y), n1 = bf4_lo(a.z, a.w); const f32x4 d0 = bf4_lo(b.x, b.y), d1 = bf4_lo(b.z, b.w);
#pragma unroll
                    for (int j = 0; j < 4; ++j) { n0[j] *= __builtin_amdgcn_rcpf(d0[j]); n1[j] *= __builtin_amdgcn_rcpf(d1[j]); }
                    acc[ai][bj][m][0] *= n0; acc[ai][bj][m][1] *= n1; }
    }
    __device__ __forceinline__ void operator()(const f32x4 (&acc)[2][2][4][2], const Unit& u, int wr, int wc, int fr, int fq) const {
        const int row0 = u.pm * BM + wr * 64 + fr, col0 = u.pn * BM + wc * 64 + 8 * fq;
        const bf16_t* gbase = G + ((size_t)((u.pm * 8 + u.pn) * 3 + (u.rot + 2) % 3) * 8 + (wr * 4 + wc)) * 8192 + (fq * 16 + fr) * 8;
        u32x4 gq[16];
#pragma unroll
        for (int q = 0; q < 16; ++q) gq[q] = GATE_NT ? __builtin_nontemporal_load((const u32x4*)(gbase + q * 512)) : *(const u32x4*)(gbase + q * 512);
#pragma unroll
        for (int ai = 0; ai < 2; ++ai)
#pragma unroll
            for (int m = 0; m < 4; ++m) { bf16_t* yp = Y + (size_t)(row0 + ai * HALF + m * 16) * ldc + col0;
#pragma unroll
                for (int bj = 0; bj < 2; ++bj) { const u32x4 a = gq[ai * 8 + m * 2 + bj];
                    *(u32x4*)(yp + bj * 32) = pack8(acc[ai][bj][m][0] * bf4_lo(a.x, a.y), acc[ai][bj][m][1] * bf4_lo(a.z, a.w)); } }
    }
};
struct EpiOut {
    static constexpr bool PERM = false, AFTER_DRAIN = false, HEADPERM = false, MIDHOOK = false;
    const float* X; float* O; int ldc;
    __device__ __forceinline__ void operator()(const f32x4 (&acc)[2][2][4][2], const Unit& u, int wr, int wc, int fr, int fq) const {
        const int row0 = u.pm * BM + wr * 64 + fr, col0 = u.pn * BM + wc * 32 + 4 * fq;
#pragma unroll
        for (int ai = 0; ai < 2; ++ai) { f32x4 xv[4][2][2];
#pragma unroll
            for (int m = 0; m < 4; ++m) { const size_t off = (size_t)(row0 + ai * HALF + m * 16) * ldc + col0;
#pragma unroll
                for (int bj = 0; bj < 2; ++bj)
#pragma unroll
                    for (int n = 0; n < 2; ++n) xv[m][bj][n] = *(const f32x4*)(X + off + bj * HALF + n * 16); }
#pragma unroll
            for (int m = 0; m < 4; ++m) { const size_t off = (size_t)(row0 + ai * HALF + m * 16) * ldc + col0;
#pragma unroll
                for (int bj = 0; bj < 2; ++bj)
#pragma unroll
                    for (int n = 0; n < 2; ++n) *(f32x4*)(O + off + bj * HALF + n * 16) = xv[m][bj][n] + acc[ai][bj][m][n]; } }
    }
};

template <class Epi, class Sched, bool ALIGN_EPI = false, bool SP2 = false>
__device__ __forceinline__ void gemm_phase(PG8_LAS unsigned char* lds, const Gemm g, const Sched& S, const Epi& E) {
    const int tid = threadIdx.x, wid = __builtin_amdgcn_readfirstlane(tid >> 6), lane = tid & 63, wr = wid >> 2, wc = wid & 3, fr = lane & 15, fq = lane >> 4;
    const int K = g.K, nt = K / BK;
    unsigned voffA[2], voffB[2];
#pragma unroll
    for (int i = 0; i < 2; ++i) { int R, C; stage_rc(tid * 16 + i * 8192, R, C); const int Rb = Epi::HEADPERM ? ((R >> 5) * 64 + perm32(R & 31)) : (Epi::PERM ? ((R & ~31) + perm32(R & 31)) : R);
        voffA[i] = (unsigned)(R * K + C) * 2u; voffB[i] = (unsigned)(Rb * K + C) * 2u; }
    const size_t kstep = (size_t)(BK * 2);
    const size_t hstep = (size_t)HALF * K * 2;
    const size_t tstep = 2 * hstep;
    const size_t hstepB = Epi::HEADPERM ? (size_t)32 * K * 2 : hstep;
    const unsigned ldsw = (unsigned)wid * 1024u;
    const int aoff = lds_byte(wr * 64 + fr, fq * 8), boff = lds_byte(wc * 32 + fr, fq * 8);
#define PG8_SA(b, h) (((b) * 2 + (h)) * HTB)
#define PG8_SB(b, h) ((4 + (b) * 2 + (h)) * HTB)
#define PG8_STAGE(bufoff, gbase, voff) do { _Pragma("unroll") for (int _i = 0; _i < 2; ++_i) \
        __builtin_amdgcn_global_load_lds((const unsigned*)((const char*)(gbase) + (voff)[_i]), (PG8_LAS unsigned*)(lds + (bufoff) + ldsw + _i * 8192), 16, 0, 0); } while (0)
#define PG8_LDA(dst, b, h) do { _Pragma("unroll") for (int m = 0; m < 4; ++m) _Pragma("unroll") for (int k = 0; k < 2; ++k) dst[m][k] = *(const PG8_LAS bf16x8*)(lds + PG8_SA(b, h) + aoff + m * 2048 + k * 1024); } while (0)
#define PG8_LDB(dst, b, h) do { _Pragma("unroll") for (int n = 0; n < 2; ++n) _Pragma("unroll") for (int k = 0; k < 2; ++k) dst[n][k] = *(const PG8_LAS bf16x8*)(lds + PG8_SB(b, h) + boff + n * 2048 + k * 1024); } while (0)
#define PG8_MMA(ai, bj, At, Bt) do { __builtin_amdgcn_s_setprio(1); _Pragma("unroll") for (int m = 0; m < 4; ++m) _Pragma("unroll") for (int n = 0; n < 2; ++n) _Pragma("unroll") for (int k = 0; k < 2; ++k) \
        acc[ai][bj][m][n] = __builtin_amdgcn_mfma_f32_16x16x32_bf16(Bt[n][k], At[m][k], acc[ai][bj][m][n], 0, 0, 0); __builtin_amdgcn_s_setprio(0); } while (0)
#define PG8_WAIT_V(n) asm volatile("s_waitcnt vmcnt(" #n ")" ::: "memory")
#define PG8_WAIT_L(n) asm volatile("s_waitcnt lgkmcnt(" #n ")" ::: "memory")
#define PG8_BAR __builtin_amdgcn_s_barrier()
#define PG8_SCHED __builtin_amdgcn_sched_barrier(0)
    Unit cur, nxt; int ui = 0;
    if (!S.next(0, cur)) return;
    f32x4 acc[2][2][4][2];
#pragma unroll
    for (int a = 0; a < 2; ++a)
#pragma unroll
        for (int b = 0; b < 2; ++b)
#pragma unroll
            for (int m = 0; m < 4; ++m)
#pragma unroll
                for (int n = 0; n < 2; ++n) acc[a][b][m][n] = (f32x4){0.f, 0.f, 0.f, 0.f};
    bf16x8 At[4][2], B0[2][2], B1[2][2];
    int ks = 0, h1 = -1, h2 = -1;
    if constexpr (Epi::MIDHOOK) { cur.rot = P3_ROT ? ((int)blockIdx.x & 7) % 3 : 0; ks = 12 * cur.rot; h1 = (cur.rot == 2) ? 8 : 12; h2 = (cur.rot == 0) ? 24 : 20; }
    auto off = [&](int p) -> ptrdiff_t { if constexpr (Epi::MIDHOOK) return (ptrdiff_t)((p + ks >= nt) ? p - nt : p) * (ptrdiff_t)(BK * 2); else return (ptrdiff_t)p * (ptrdiff_t)(BK * 2); };
    const char* cA = (const char*)g.A + (size_t)cur.pm * tstep + (size_t)ks * (BK * 2); const char* cB = (const char*)g.Bt + (size_t)cur.pn * tstep + (size_t)ks * (BK * 2);
    S.a_ready(cur);
    if constexpr (SP2) {
        PG8_STAGE(PG8_SB(0, 0), cB, voffB); PG8_STAGE(PG8_SB(0, 1), cB + hstepB, voffB); PG8_STAGE(PG8_SA(0, 0), cA, voffA); PG8_STAGE(PG8_SA(0, 1), cA + hstep, voffA);
        if (wr == 1) PG8_BAR;
        PG8_WAIT_V(2); PG8_BAR;
        PG8_STAGE(PG8_SB(1, 0), cB + kstep, voffB); PG8_STAGE(PG8_SA(1, 0), cA + kstep, voffA); PG8_STAGE(PG8_SB(1, 1), cB + hstepB + kstep, voffB);
        PG8_WAIT_V(6); PG8_BAR;
    } else {
        PG8_STAGE(PG8_SB(0, 0), cB, voffB); PG8_STAGE(PG8_SA(0, 0), cA, voffA); PG8_STAGE(PG8_SB(0, 1), cB + hstepB, voffB); PG8_STAGE(PG8_SA(0, 1), cA + hstep, voffA);
        if (wr == 1) PG8_BAR;
        PG8_WAIT_V(4); PG8_BAR;
        PG8_STAGE(PG8_SB(1, 0), cB + kstep, voffB); PG8_STAGE(PG8_SA(1, 0), cA + kstep, voffA); PG8_STAGE(PG8_SB(1, 1), cB + hstepB + kstep, voffB);
        PG8_WAIT_V(6); PG8_BAR;
    }
    for (;;) {
        const bool has_next = S.next(ui + 1, nxt);
        if constexpr (Epi::MIDHOOK) { if (has_next) nxt.rot = cur.rot; }
        const char* nA = has_next ? (const char*)g.A + (size_t)nxt.pm * tstep + (size_t)ks * (BK * 2) : cA; const char* nB = has_next ? (const char*)g.Bt + (size_t)nxt.pn * tstep + (size_t)ks * (BK * 2) : cB;
        for (int t = 0; t < nt; t += 2) {
            if constexpr (Epi::MIDHOOK) { if (t == h1 || t == h2) E.mid(acc, cur, wr, wc, fr, fq, (t == h1) ? cur.rot : (cur.rot + 1) % 3); }
            const bool last = (t == nt - 2);
            const char* a1 = cA + off(t + 1);
            const char* a2 = last ? nA : cA + off(t + 2); const char* b2 = last ? nB : cB + off(t + 2);
            const char* a3 = a2 + kstep; const char* b3 = b2 + kstep;
            if (last && has_next) S.a_ready(nxt);
            if constexpr (SP2) {
            PG8_LDB(B0, 0, 0); PG8_LDB(B1, 0, 1); PG8_SCHED; PG8_LDA(At, 0, 0); PG8_STAGE(PG8_SA(1, 1), a1 + hstep, voffA);
            PG8_WAIT_V(8); PG8_WAIT_L(0); PG8_BAR; PG8_MMA(0, 0, At, B0); PG8_MMA(0, 1, At, B1); PG8_BAR; PG8_SCHED;
            PG8_LDA(At, 0, 1); PG8_STAGE(PG8_SB(0, 0), b2, voffB); PG8_STAGE(PG8_SB(0, 1), b2 + hstepB, voffB); PG8_STAGE(PG8_SA(0, 0), a2, voffA);
            PG8_WAIT_V(8); PG8_WAIT_L(0); PG8_BAR; PG8_MMA(1, 0, At, B0); PG8_MMA(1, 1, At, B1); PG8_BAR; PG8_SCHED;
            PG8_LDB(B0, 1, 0); PG8_LDB(B1, 1, 1); PG8_SCHED; PG8_LDA(At, 1, 0); PG8_STAGE(PG8_SA(0, 1), a2 + hstep, voffA);
            PG8_WAIT_V(8); PG8_WAIT_L(0); PG8_BAR; PG8_MMA(0, 0, At, B0); PG8_MMA(0, 1, At, B1); PG8_BAR; PG8_SCHED;
            PG8_LDA(At, 1, 1); PG8_STAGE(PG8_SB(1, 0), b3, voffB); PG8_STAGE(PG8_SB(1, 1), b3 + hstepB, voffB); PG8_STAGE(PG8_SA(1, 0), a3, voffA);
            PG8_WAIT_V(8); PG8_WAIT_L(0); PG8_BAR; PG8_MMA(1, 0, At, B0); PG8_MMA(1, 1, At, B1); PG8_BAR; PG8_SCHED;
            } else {
            PG8_LDB(B0, 0, 0); PG8_SCHED; PG8_LDA(At, 0, 0); PG8_STAGE(PG8_SA(1, 1), a1 + hstep, voffA);
            PG8_WAIT_L(8); PG8_BAR; PG8_WAIT_L(0); PG8_MMA(0, 0, At, B0); PG8_BAR; PG8_SCHED;
            PG8_LDB(B1, 0, 1); PG8_STAGE(PG8_SB(0, 0), b2, voffB);
            PG8_BAR; PG8_WAIT_L(0); PG8_MMA(0, 1, At, B1); PG8_BAR;
            PG8_LDA(At, 0, 1); PG8_STAGE(PG8_SA(0, 0), a2, voffA);
            PG8_BAR; PG8_WAIT_L(0); PG8_MMA(1, 0, At, B0); PG8_BAR; PG8_SCHED;
            PG8_STAGE(PG8_SB(0, 1), b2 + hstepB, voffB);
            PG8_WAIT_V(6); PG8_BAR; PG8_MMA(1, 1, At, B1); PG8_BAR;
            PG8_LDB(B0, 1, 0); PG8_SCHED; PG8_LDA(At, 1, 0); PG8_STAGE(PG8_SA(0, 1), a2 + hstep, voffA);
            PG8_WAIT_L(8); PG8_BAR; PG8_WAIT_L(0); PG8_MMA(0, 0, At, B0); PG8_BAR; PG8_SCHED;
            PG8_LDB(B1, 1, 1); PG8_STAGE(PG8_SB(1, 0), b3, voffB);
            PG8_BAR; PG8_WAIT_L(0); PG8_MMA(0, 1, At, B1); PG8_BAR;
            PG8_LDA(At, 1, 1); PG8_STAGE(PG8_SA(1, 0), a3, voffA);
            PG8_BAR; PG8_WAIT_L(0); PG8_MMA(1, 0, At, B0); PG8_BAR; PG8_SCHED;
            PG8_STAGE(PG8_SB(1, 1), b3 + hstepB, voffB);
            PG8_WAIT_V(6); PG8_BAR; PG8_MMA(1, 1, At, B1); PG8_BAR;
            }
        }
        if constexpr (ALIGN_EPI) { if (wr == 0) PG8_BAR; }
        if constexpr (!Epi::AFTER_DRAIN) { E(acc, cur, wr, wc, fr, fq); S.done(cur); }
        if (!has_next) break;
#pragma unroll
        for (int a = 0; a < 2; ++a)
#pragma unroll
            for (int b = 0; b < 2; ++b)
#pragma unroll
                for (int m = 0; m < 4; ++m)
#pragma unroll
                    for (int n = 0; n < 2; ++n) acc[a][b][m][n] = (f32x4){0.f, 0.f, 0.f, 0.f};
        cur = nxt; cA = nA; cB = nB; ++ui;
        if constexpr (ALIGN_EPI) { if (wr == 1) PG8_BAR; }
    }
    PG8_WAIT_V(0);
    if constexpr (!ALIGN_EPI) { if (wr == 0) PG8_BAR; }
    PG8_BAR;
    if constexpr (Epi::AFTER_DRAIN) { E.fused(acc, cur, wr, wc, fr, fq, lds, wid, lane); S.done(cur); }
#undef PG8_SA
#undef PG8_SB
#undef PG8_STAGE
#undef PG8_LDA
#undef PG8_LDB
#undef PG8_MMA
#undef PG8_WAIT_V
#undef PG8_WAIT_L
#undef PG8_BAR
#undef PG8_SCHED
}
}
#define GAS __attribute__((address_space(1)))
#define LAS __attribute__((address_space(3)))
typedef unsigned v4u __attribute__((ext_vector_type(4)));
typedef float f32x4 __attribute__((ext_vector_type(4)));
typedef short bf16x8 __attribute__((ext_vector_type(8)));
typedef GAS unsigned gu32;
typedef GAS unsigned long long gu64;
#define RLX_AGENT __ATOMIC_RELAXED, __HIP_MEMORY_SCOPE_AGENT
#define LDS_WAIT() asm volatile("s_waitcnt lgkmcnt(0)" ::: "memory")
#define VM_WAIT() asm volatile("s_waitcnt vmcnt(0)" ::: "memory")
__device__ __forceinline__ unsigned long long rt() { return __builtin_amdgcn_s_memrealtime(); }

#define XB_TMO      128
#define XB_XCNT(j)  (256  + 64 * (j))
#define XB_XSUB(j)  (1280 + 64 * (j))
#define XB_XGEN(j)  (2304 + 64 * (j))
#define XB_TOP      3328
#define XB_TOPGEN   3392
#define XCD_BAR_WORDS 3456
#define XB_SPIN_CAP (1u << 18)

__device__ __forceinline__ unsigned xb_ld(unsigned* p)              { return __hip_atomic_load(p, __ATOMIC_RELAXED, __HIP_MEMORY_SCOPE_AGENT); }
__device__ __forceinline__ unsigned xb_add(unsigned* p, unsigned v) { return __hip_atomic_fetch_add(p, v, __ATOMIC_RELAXED, __HIP_MEMORY_SCOPE_AGENT); }
__device__ __forceinline__ unsigned xb_xcc_id() { return (unsigned)__builtin_amdgcn_s_getreg((3 << 11) | 20) & 0xFu; }
#define XB_SPIN(cond, bar) do { unsigned _sp = 0; while (cond) { __builtin_amdgcn_s_sleep(1); \
    if ((++_sp & 255u) == 0u) { if (xb_ld(&(bar)[XB_TMO])) break; if (_sp > XB_SPIN_CAP) { atomicAdd(&(bar)[XB_TMO], 1u); break; } } } } while (0)

struct XcdBarrier {
    unsigned* bar; unsigned x;
    volatile LAS unsigned* st;
};

__device__ __forceinline__ XcdBarrier xcd_barrier_post(unsigned* bar, volatile LAS unsigned* st) {
    XcdBarrier b; b.bar = bar; b.x = xb_xcc_id(); b.st = st;
    if (threadIdx.x == 0) (void)xb_add(&bar[XB_XCNT(b.x)], 1u);
    return b;
}
__device__ __forceinline__ void xcd_barrier_complete(unsigned* bar, unsigned x, unsigned& nloc, unsigned& nx) {
    const unsigned G = gridDim.x * gridDim.y * gridDim.z;
    unsigned sum, cnt, mine, sp = 0u;
    for (;;) {
        sum = 0u; cnt = 0u; mine = 0u;
#pragma unroll
        for (unsigned j = 0; j < 16; ++j) { const unsigned c = xb_ld(&bar[XB_XCNT(j)]); sum += c; cnt += (c > 0u) ? 1u : 0u; mine = (j == x) ? c : mine; }
        if (sum == G) break;
        __builtin_amdgcn_s_sleep(1);
        if ((++sp & 255u) == 0u) { if (xb_ld(&bar[XB_TMO])) break; if (sp > XB_SPIN_CAP) { atomicAdd(&bar[XB_TMO], 1u); break; } }
    }
    nloc = mine > 0u ? mine : 1u; nx = cnt > 0u ? cnt : 1u;
}

__device__ __forceinline__ void xcd_barrier(const XcdBarrier& b) {
    asm volatile("s_waitcnt vmcnt(0)" ::: "memory");
    __syncthreads();
    if (threadIdx.x == 0) {
        unsigned* bar = b.bar;
        __builtin_amdgcn_s_waitcnt(0);
        unsigned nloc = b.st[0], nx = b.st[1];
        if (nloc == 0u) { xcd_barrier_complete(bar, b.x, nloc, nx); b.st[0] = nloc; b.st[1] = nx; }
        const unsigned old = xb_add(&bar[XB_XSUB(b.x)], 1u);
        const unsigned gen = old / nloc;
        if (old + 1u == (gen + 1u) * nloc) {
            __builtin_amdgcn_fence(__ATOMIC_RELEASE, "agent");
            asm volatile("s_waitcnt vmcnt(0)" ::: "memory");
            const unsigned og = xb_add(&bar[XB_TOP], 1u);
            const unsigned tg = og / nx;
            if (og + 1u == (tg + 1u) * nx) xb_add(&bar[XB_TOPGEN], 1u);
            else XB_SPIN(xb_ld(&bar[XB_TOPGEN]) == tg, bar);
            __builtin_amdgcn_fence(__ATOMIC_ACQUIRE, "agent");
            xb_add(&bar[XB_XGEN(b.x)], 1u);
            asm volatile("s_waitcnt vmcnt(0)" ::: "memory");
        } else {
            XB_SPIN(xb_ld(&bar[XB_XGEN(b.x)]) == gen, bar);
            __builtin_amdgcn_fence(__ATOMIC_ACQUIRE, "agent");
            asm volatile("s_waitcnt vmcnt(0)" ::: "memory");
        }
    }
    __syncthreads();
}

constexpr int NWAVES = 8;
constexpr int CW_TMO = 0, CW_CODE = 1;
constexpr int CW_Q = 64;
constexpr int CW_MKF = 1024;
constexpr int CW_P0MK = 2048;
constexpr int CW_BAR = 4096;
constexpr int RING_OFF = 0, RING_BYTES = 131072;
constexpr int LDSCTL_OFF = 136192, MISC_OFF = LDSCTL_OFF + 320;
constexpr int T0L_OFF = LDSCTL_OFF + 1024;
constexpr int LDS_BYTES = 147456;
static_assert(T0L_OFF + 4736 <= LDS_BYTES && LDSCTL_OFF >= RING_BYTES, "LDS map");


namespace att {
typedef short bf16x8 __attribute__((ext_vector_type(8)));
typedef short s16x4 __attribute__((ext_vector_type(4)));
typedef short v4i16_t __attribute__((ext_vector_type(4)));
typedef float f32x16 __attribute__((ext_vector_type(16)));
typedef float f32x4 __attribute__((ext_vector_type(4)));
typedef unsigned u32x4 __attribute__((ext_vector_type(4)));
#define ALAS __attribute__((address_space(3)))
constexpr int LDS_K = 0, LDS_V = 32768, LDS_C = 65536, LDS_WS = LDS_C + 1024, LDS_OST = LDS_WS + 8 * 256, LDS_BYTES = LDS_OST + 8 * 4096;
constexpr int LDS_Q = LDS_BYTES, LDS_CSQ = LDS_Q + 32768, LDS_END = LDS_CSQ + 2048;
#ifndef QZ_NT
#define QZ_NT 1
#endif
#if QZ_NT
#define QZ_LD glds16nt
#else
#define QZ_LD glds16
#endif
#ifndef C_POS
#define C_POS 192
#endif
#ifndef PV_INTERLEAVE
#define PV_INTERLEAVE 1
#endif
#ifndef QK_SPLIT
#define QK_SPLIT 0
#endif
#ifndef EARLY_HEAD
#define EARLY_HEAD 0
#endif
constexpr int N_UNITS = 384 + 128 + 384;
#ifndef LPT_SORT
#define LPT_SORT 0
#endif
constexpr bool B128 = true;
constexpr int C_FIRST = 384 + C_POS;
__device__ __forceinline__ int crow(int r, int hi) { return (r & 3) + 8 * (r >> 2) + 4 * hi; }
__device__ __forceinline__ unsigned cvtpk(float lo, float hi) { typedef float f2 __attribute__((ext_vector_type(2))); typedef __bf16 b2 __attribute__((ext_vector_type(2))); f2 v = {lo, hi}; b2 b = __builtin_convertvector(v, b2); return __builtin_bit_cast(unsigned, b); }
__device__ __forceinline__ s16x4 vtr(const ALAS unsigned char* p) { return __builtin_bit_cast(s16x4, __builtin_amdgcn_ds_read_tr16_b64_v4i16((ALAS v4i16_t*)p)); }
#define MX3(a, b, c) __builtin_fmaxf(__builtin_fmaxf((a), (b)), (c))
__device__ __forceinline__ float rowmax(const f32x16& p0, const f32x16& p1) {
    float a = MX3(p0[0], p0[1], p1[0]), b = MX3(p0[2], p0[3], p1[1]); a = MX3(a, p1[2], p1[3]);
#pragma unroll
    for (int r = 4; r < 16; r += 4) { a = MX3(a, p0[r], p0[r + 1]); b = MX3(b, p0[r + 2], p0[r + 3]); a = MX3(a, p1[r], p1[r + 1]); b = MX3(b, p1[r + 2], p1[r + 3]); }
    float m = __builtin_fmaxf(a, b); auto rr = __builtin_amdgcn_permlane32_swap(__float_as_uint(m), __float_as_uint(m), false, false);
    return __builtin_fmaxf(__uint_as_float(rr[0]), __uint_as_float(rr[1])); }
__device__ __forceinline__ float pair_sum(float v) { auto rr = __builtin_amdgcn_permlane32_swap(__float_as_uint(v), __float_as_uint(v), false, false); return __uint_as_float(rr[0]) + __uint_as_float(rr[1]); }
__device__ __forceinline__ void glds16(const void* g, unsigned lds_dst) { unsigned keep; asm volatile("s_mov_b32 %0, m0\n\ts_mov_b32 m0, %2\n\ts_nop 0\n\tglobal_load_lds_dwordx4 %1, off\n\ts_mov_b32 m0, %0" : "=&s"(keep) : "v"(g), "s"(lds_dst) : "memory"); }
__device__ __forceinline__ void glds16nt(const void* g, unsigned lds_dst) { unsigned keep; asm volatile("s_mov_b32 %0, m0\n\ts_mov_b32 m0, %2\n\ts_nop 0\n\tglobal_load_lds_dwordx4 %1, off nt\n\ts_mov_b32 m0, %0" : "=&s"(keep) : "v"(g), "s"(lds_dst) : "memory"); }
__device__ __forceinline__ void glds4(const void* g, unsigned lds_dst) { unsigned keep; asm volatile("s_mov_b32 %0, m0\n\ts_mov_b32 m0, %2\n\ts_nop 0\n\tglobal_load_lds_dword %1, off\n\ts_mov_b32 m0, %0" : "=&s"(keep) : "v"(g), "s"(lds_dst) : "memory"); }
#define WAIT_BAR(N) asm volatile("s_waitcnt vmcnt(" #N ") lgkmcnt(0)\n\ts_barrier" ::: "memory")
#define LGKM_BAR() asm volatile("s_waitcnt lgkmcnt(0)\n\ts_barrier" ::: "memory")

#if defined(PROBE_REPEAT) && (PROBE_REPEAT == 7 || PROBE_REPEAT == 8 || PROBE_REPEAT == 11 || PROBE_REPEAT == 12 || PROBE_REPEAT == 13 || PROBE_REPEAT == 14 || (PROBE_REPEAT >= 40 && PROBE_REPEAT < 50))
#define PROBE_MAP(u) (u)
#else
#if defined(PROBE_REPEAT) && PROBE_REPEAT == 67
#define PROBE_MAP(u) (T.pflag ? (u) % 384 : (u))
#else
#define PROBE_MAP(u) (((u) >= att::N_UNITS) ? (u) - 512 : (u))
#endif
#endif
struct Tensors { unsigned char* ws; const float* sinks; const float* g_qc; const float* g_kc; const ALAS int* t0tab; const unsigned* mkf; int pflag; unsigned* qctr; unsigned q_lo; unsigned short* ubase;
    __device__ __forceinline__ const unsigned short* PG() const { return (const unsigned short*)(ws + WS_PG); }
    __device__ __forceinline__ const unsigned short* QA() const { return (const unsigned short*)(ws + WS_QA); }
    __device__ __forceinline__ const unsigned short* ZA() const { return (const unsigned short*)(ws + WS_ZA); }
    __device__ __forceinline__ const unsigned short* QB() const { return (const unsigned short*)(ws + WS_QB); }
    __device__ __forceinline__ const unsigned short* ZB() const { return (const unsigned short*)(ws + WS_ZB); }
    __device__ __forceinline__ const unsigned short* KB() const { return (const unsigned short*)(ws + WS_KB); }
    __device__ __forceinline__ const unsigned short* VB() const { return (const unsigned short*)(ws + WS_VB); }
    __device__ __forceinline__ const unsigned short* KA() const { return (const unsigned short*)(ws + WS_KA); }
    __device__ __forceinline__ const unsigned short* VA() const { return (const unsigned short*)(ws + WS_VA); }
    __device__ __forceinline__ const unsigned short* MKV() const { return (const unsigned short*)(ws + WS_MKV); }
    __device__ __forceinline__ const float* CS2() const { return (const float*)(ws + WS_CS2); }
    __device__ __forceinline__ unsigned short* U() const { return ubase; }
    __device__ __forceinline__ unsigned short* U2() const { return (unsigned short*)(ws + WS_END + 2 * MiB); }
};
struct Desc { int kind, b, h, qb, T0, NT, dummy, s0, early, after; };
struct Geo { const unsigned short* Ksrc; const unsigned short* Vsrc; const float* csrow; int pitch; };

__device__ __forceinline__ Desc decode(int u, const ALAS int* t0tab) {
    Desc d; d.dummy = 0; d.s0 = 0; d.early = 0; d.after = 0;
#if defined(PROBE_REPEAT)
    int forceband = 0; if ((PROBE_REPEAT == 12 || PROBE_REPEAT == 13 || PROBE_REPEAT == 14 || (PROBE_REPEAT >= 40 && PROBE_REPEAT < 50)) && u >= N_UNITS) { u -= N_UNITS; d.dummy = 1; forceband = (PROBE_REPEAT == 12); }
    if (PROBE_REPEAT == 7 && u >= N_UNITS) u = 512 + (u - N_UNITS); if (PROBE_REPEAT == 8 && u >= N_UNITS) u = u - N_UNITS; if (PROBE_REPEAT == 11 && u >= N_UNITS) u = 384 + (u - N_UNITS);
#endif
    if (u < 384) { if (LPT_SORT) u = __builtin_amdgcn_readfirstlane(t0tab[384 + u]);
        const int bh = u % 24; d.kind = 1; d.qb = 15 - u / 24; d.b = bh / 12; d.h = bh % 12; d.T0 = __builtin_amdgcn_readfirstlane(t0tab[bh * 16 + d.qb]);
#if defined(PROBE_REPEAT)
        if (PROBE_REPEAT == 9) d.T0 = 0;
        if (PROBE_REPEAT == 10) { d.T0 -= 8; if (d.T0 < 0) d.T0 = 0; }
        if (forceband) d.T0 = d.qb * 4;
        if (PROBE_REPEAT == 50 || PROBE_REPEAT == 67) { const int fnt = __builtin_amdgcn_readfirstlane(t0tab[1152]); if (fnt > 0) { d.T0 = d.qb * 4 + 4 - fnt; if (d.T0 < 0) d.T0 = 0; } }
#endif
        d.NT = d.qb * 4 + 4 - d.T0; if (B128 && (d.NT & 1)) { d.T0 -= 1; d.NT += 1; } }
    else if (u >= C_FIRST && u < C_FIRST + 128) { const int v = u - C_FIRST, bh = v % 8; d.kind = 2; d.qb = v / 8; d.b = bh / 4; d.h = bh % 4; d.T0 = 0; d.NT = MEMT / 64; }
    else { const int v = (u < C_FIRST) ? u - 384 : u - 512, bh = v % 24; d.kind = 0; d.qb = v / 24; d.b = bh / 12; d.h = bh % 12; d.T0 = d.qb * 4 - 2; if (d.T0 < 0) d.T0 = 0; d.NT = d.qb * 4 + 4 - d.T0; }
    return d;
}
__device__ __forceinline__ Geo geo(const Tensors& T, const Desc& d) {
    Geo g;
    if (d.kind == 0) { const int kvh = d.h / 3; g.Ksrc = T.KA() + (size_t)(d.b * 4 + kvh) * 64 * 4096; g.Vsrc = T.VA() + (size_t)(d.b * 4 + kvh) * 64 * 4096; g.pitch = 0; g.csrow = T.CS2(); }
    else if (d.kind == 1) { g.Ksrc = T.KB() + (size_t)(d.b * 12 + d.h) * 64 * 4096; g.Vsrc = T.VB() + (size_t)(d.b * 12 + d.h) * 64 * 4096; g.pitch = 0; g.csrow = T.CS2() + ((size_t)d.b * 12 + d.h) * SEQ; }
    else { g.Ksrc = T.MKV() + (size_t)(d.b * 4 + d.h) * 4 * 8192; g.Vsrc = g.Ksrc + 262144; g.pitch = 0; g.csrow = T.CS2(); }
    return g;
}
__device__ __forceinline__ void issue_tile(const Geo& g, int kind, int tile, int s, unsigned lds0, int wid, int lane) {
    const size_t kr = (size_t)tile * 64;
    if (kind != 2) {
        const size_t to = (size_t)tile * 4096 + wid * 512 + lane * 8;
        glds16(g.Ksrc + to, (unsigned)__builtin_amdgcn_readfirstlane((int)(lds0 + LDS_K + s * 8192 + wid * 1024)));
        glds16(g.Vsrc + to, (unsigned)__builtin_amdgcn_readfirstlane((int)(lds0 + LDS_V + s * 8192 + wid * 1024)));
        if (kind == 1 && wid == 0) glds4(g.csrow + kr + lane, (unsigned)__builtin_amdgcn_readfirstlane((int)(lds0 + LDS_C + s * 256)));
    } else {
#pragma unroll
        for (int c = 0; c < 2; ++c) { const int p = wid + 8 * c;
            const size_t to = (size_t)tile * 8192 + p * 512 + lane * 8;
            glds16(g.Ksrc + to, (unsigned)__builtin_amdgcn_readfirstlane((int)(lds0 + LDS_K + s * 16384 + p * 1024)));
            glds16(g.Vsrc + to, (unsigned)__builtin_amdgcn_readfirstlane((int)(lds0 + LDS_V + s * 16384 + p * 1024))); }
    }
}
__device__ __forceinline__ void issue_pair(const Geo& g, int kind, int last, int pr, int s, unsigned lds0, int wid, int lane) {
    const int tlo = last - 2 * pr - 1;
#pragma unroll
    for (int img = 0; img < 2; ++img) { const size_t to = (size_t)(tlo + img) * 4096 + wid * 512 + lane * 8;
        glds16(g.Ksrc + to, (unsigned)__builtin_amdgcn_readfirstlane((int)(lds0 + LDS_K + s * 16384 + img * 8192 + wid * 1024)));
        glds16(g.Vsrc + to, (unsigned)__builtin_amdgcn_readfirstlane((int)(lds0 + LDS_V + s * 16384 + img * 8192 + wid * 1024))); }
    if (kind == 1 && wid == 0) { glds4(g.csrow + (size_t)tlo * 64 + lane, (unsigned)__builtin_amdgcn_readfirstlane((int)(lds0 + LDS_C + s * 512)));
                    glds4(g.csrow + (size_t)tlo * 64 + 64 + lane, (unsigned)__builtin_amdgcn_readfirstlane((int)(lds0 + LDS_C + s * 512 + 256))); }
}
__device__ __forceinline__ void issue_head(const Tensors& T, const Geo& g, const Desc& d, unsigned lds0, int wid, int lane) {
    const int last = d.T0 + d.NT - 1;
    if (d.kind != 2) {
        const unsigned short* qb = (d.kind == 0 ? T.QA() : T.QB()) + ((size_t)(d.b * 12 + d.h) * SEQ + d.qb * 256 + wid * 32) * 64;
#pragma unroll
        for (int i = 0; i < 4; ++i) QZ_LD(qb + (i * 8 + (lane >> 3)) * 64 + (((lane & 7) ^ (lane >> 3)) * 8), (unsigned)__builtin_amdgcn_readfirstlane((int)(lds0 + LDS_Q + wid * 4096 + i * 1024)));
        if (d.kind == 1) glds4(T.CS2() + ((size_t)d.b * 12 + d.h) * SEQ + d.qb * 256 + wid * 32 + lane, (unsigned)__builtin_amdgcn_readfirstlane((int)(lds0 + LDS_CSQ + wid * 256)));
        issue_pair(g, d.kind, last, 0, d.s0, lds0, wid, lane);
    } else issue_tile(g, 2, last, d.s0, lds0, wid, lane);
}
__device__ __forceinline__ void issue_rest(const Geo& g, const Desc& d, unsigned lds0, int wid, int lane) {
    if (d.kind != 2 && d.NT > 2) issue_pair(g, d.kind, d.T0 + d.NT - 1, 1, d.s0 ^ 1, lds0, wid, lane);
}

template <int KIND, int ABL = 0> __device__ __forceinline__ void unit(const Tensors& T, const Desc& dsc, ALAS unsigned char* lds, volatile ALAS unsigned* misc, unsigned nidx, int n_total, int& next_u, Desc& nd) {
    constexpr int DH = (KIND == 2) ? 128 : 64, ND = DH / 16, NO = DH / 32;
    constexpr bool RING = (KIND != 2);
    constexpr int SLOT = RING ? 8192 : 16384;
    int tid = threadIdx.x; asm volatile("" : "+v"(tid));
    const int lane = tid & 63, r32 = lane & 31, hi = lane >> 5; const int wid = __builtin_amdgcn_readfirstlane(tid >> 6);
    unsigned qnext = 1u;
    const int b = dsc.b, h = dsc.h, q0 = dsc.qb * 256, T0 = dsc.T0, NT = dsc.NT; const size_t rowbase = (size_t)b * SEQ;
    const int qabs = q0 + wid * 32 + r32;
    const Geo g = geo(T, dsc);
    const int ucol = (KIND == 0) ? h * 64 : (KIND == 1) ? 768 + h * 64 : 1536 + h * 128;
    const int qzp = (KIND == 2) ? PGW : 64;
    const unsigned short* qbase_ = (KIND == 0) ? T.QA() + ((size_t)(b * 12 + h) * SEQ + q0 + wid * 32) * 64 : (KIND == 1) ? T.QB() + ((size_t)(b * 12 + h) * SEQ + q0 + wid * 32) * 64 : T.PG() + (rowbase + q0 + wid * 32) * PGW + PG_QC + h * 128;
    const unsigned short* zrow_ = (KIND == 0) ? T.ZA() + ((size_t)(b * 12 + h) * SEQ + q0 + wid * 32) * 64 : (KIND == 1) ? T.ZB() + ((size_t)(b * 12 + h) * SEQ + q0 + wid * 32) * 64 : T.PG() + (rowbase + q0 + wid * 32) * PGW + PG_ZC + h * 128;
    const unsigned short* qbase = qbase_; const unsigned short* zrow = zrow_;
#if defined(PROBE_REPEAT)
    if (T.pflag && (PROBE_REPEAT == 55 || PROBE_REPEAT == 56 || PROBE_REPEAT == 64)) { qbase = T.QA() + (size_t)(wid * 32) * 64; }
    if (T.pflag && (PROBE_REPEAT == 55 || PROBE_REPEAT == 57 || PROBE_REPEAT == 64)) { zrow = T.ZA() + (size_t)(wid * 32) * 64; }
#endif
    const unsigned lds0 = (unsigned)(size_t)lds;
    auto knorm = [&](int s) {
        const int row = tid >> 3, c0 = (tid & 7) * 2; ALAS unsigned char* kb = lds + LDS_K + s * SLOT + row * 16;
        bf16x8 a = *(const ALAS bf16x8*)(kb + c0 * 1024), c = *(const ALAS bf16x8*)(kb + (c0 + 1) * 1024);
        float fa[8], fc[8]; float ss = 0.f;
#pragma unroll
        for (int j = 0; j < 8; ++j) { fa[j] = __uint_as_float((unsigned)(unsigned short)a[j] << 16); fc[j] = __uint_as_float((unsigned)(unsigned short)c[j] << 16); ss += fa[j] * fa[j] + fc[j] * fc[j]; }
        ss += __builtin_bit_cast(float, __builtin_amdgcn_ds_swizzle(__builtin_bit_cast(int, ss), (1 << 10) | 0x1f)); ss += __builtin_bit_cast(float, __builtin_amdgcn_ds_swizzle(__builtin_bit_cast(int, ss), (2 << 10) | 0x1f));
        ss += __builtin_bit_cast(float, __builtin_amdgcn_ds_swizzle(__builtin_bit_cast(int, ss), (4 << 10) | 0x1f));
        const float rk = __builtin_amdgcn_rsqf(ss * (1.f / 128.f) + EPS);
        const f32x4 g0 = *(const f32x4*)(T.g_kc + c0 * 8), g1 = *(const f32x4*)(T.g_kc + c0 * 8 + 4), g2 = *(const f32x4*)(T.g_kc + c0 * 8 + 8), g3 = *(const f32x4*)(T.g_kc + c0 * 8 + 12);
        u32x4 oa, oc;
        oa.x = cvtpk(fa[0] * rk * g0[0], fa[1] * rk * g0[1]); oa.y = cvtpk(fa[2] * rk * g0[2], fa[3] * rk * g0[3]); oa.z = cvtpk(fa[4] * rk * g1[0], fa[5] * rk * g1[1]); oa.w = cvtpk(fa[6] * rk * g1[2], fa[7] * rk * g1[3]);
        oc.x = cvtpk(fc[0] * rk * g2[0], fc[1] * rk * g2[1]); oc.y = cvtpk(fc[2] * rk * g2[2], fc[3] * rk * g2[3]); oc.z = cvtpk(fc[4] * rk * g3[0], fc[5] * rk * g3[1]); oc.w = cvtpk(fc[6] * rk * g3[2], fc[7] * rk * g3[3]);
        *(ALAS u32x4*)(kb + c0 * 1024) = oa; *(ALAS u32x4*)(kb + (c0 + 1) * 1024) = oc;
    };
    bf16x8 qr[ND]; float csq = 0.f;
    if (KIND != 2) {
        switch (dsc.after) { case 4: asm volatile("s_waitcnt vmcnt(4)" ::: "memory"); break; case 8: asm volatile("s_waitcnt vmcnt(8)" ::: "memory"); break; case 10: asm volatile("s_waitcnt vmcnt(10)" ::: "memory"); break;
                             case 12: asm volatile("s_waitcnt vmcnt(12)" ::: "memory"); break; case 14: asm volatile("s_waitcnt vmcnt(14)" ::: "memory"); break; default: asm volatile("s_waitcnt vmcnt(0)" ::: "memory"); break; }
#pragma unroll
        for (int d0 = 0; d0 < ND; ++d0) qr[d0] = *(const ALAS bf16x8*)(lds + LDS_Q + wid * 4096 + r32 * 128 + (((2 * d0 + hi) ^ (r32 & 7)) * 16));
        if (KIND == 1) csq = *(const ALAS float*)(lds + LDS_CSQ + wid * 256 + r32 * 4);
#pragma unroll
        for (int i = 0; i < 4; ++i) QZ_LD(zrow + i * 512 + lane * 8, (unsigned)__builtin_amdgcn_readfirstlane((int)(lds0 + LDS_OST + wid * 4096 + i * 1024)));
    } else {
        const unsigned short* Qw = qbase + (size_t)r32 * qzp + hi * 8;
#pragma unroll
        for (int d0 = 0; d0 < ND; ++d0) qr[d0] = *(const bf16x8*)(Qw + d0 * 16);
    }
    if (tid == 0) { typedef __attribute__((address_space(1))) unsigned gu32a; gu32a* qp = (gu32a*)T.qctr; asm volatile("" : "+v"(qp));
        qnext = __hip_atomic_fetch_add(qp, 1u, __ATOMIC_RELAXED, __HIP_MEMORY_SCOPE_AGENT); }
    if (KIND == 2) {
        float ss = 0.f;
#pragma unroll
        for (int d0 = 0; d0 < ND; ++d0)
#pragma unroll
            for (int j = 0; j < 8; ++j) { const float f = __uint_as_float((unsigned)(unsigned short)qr[d0][j] << 16); ss += f * f; }
        ss = pair_sum(ss);
        const float rq = C2_128 * __builtin_amdgcn_rsqf(ss * (1.f / 128.f) + EPS);
#pragma unroll
        for (int d0 = 0; d0 < ND; ++d0) { const f32x4 g0 = *(const f32x4*)(T.g_qc + d0 * 16 + hi * 8), g1 = *(const f32x4*)(T.g_qc + d0 * 16 + hi * 8 + 4); u32x4 w;
            float f[8];
#pragma unroll
            for (int j = 0; j < 8; ++j) f[j] = __uint_as_float((unsigned)(unsigned short)qr[d0][j] << 16) * rq;
            w.x = cvtpk(f[0] * g0[0], f[1] * g0[1]); w.y = cvtpk(f[2] * g0[2], f[3] * g0[3]); w.z = cvtpk(f[4] * g1[0], f[5] * g1[1]); w.w = cvtpk(f[6] * g1[2], f[7] * g1[3]);
            qr[d0] = __builtin_bit_cast(bf16x8, w); }
    }
#if defined(THR_TEST)
    constexpr float THR = -1000.f;
#else
    constexpr float THR = 8.f;
#endif
    float slope2 = 0.f, mref = 0.f; bool started = (KIND == 0);
    if (KIND == 0) { slope2 = __builtin_amdgcn_exp2f(-8.f * (float)(h + 1) * (1.f / 12.f)) * LOG2E; mref = ((const ALAS float*)T.t0tab)[1160 + h] * LOG2E; }
    f32x16 o[NO], lacc;
#pragma unroll
    for (int d = 0; d < NO; ++d) o[d] = f32x16{};
    { float l0 = (KIND == 0) ? 1.f : 0.f; asm volatile("" : "+v"(l0));
#pragma unroll
      for (int r = 0; r < 16; ++r) lacc[r] = l0; }
    const bf16x8 ones = (bf16x8){0x3f80, 0x3f80, 0x3f80, 0x3f80, 0x3f80, 0x3f80, 0x3f80, 0x3f80};
    ALAS float* wsf = (ALAS float*)(lds + LDS_WS) + wid * 64;
    const int vbl = ((lane >> 4) & 1) * 32 + (lane & 3) * 8 + (4 * hi + ((lane & 15) >> 2)) * 64;
#pragma unroll
    for (int d0 = 0; d0 < ND; ++d0) asm volatile("" : "+v"(qr[d0]));
    asm volatile("" : "+v"(csq), "+v"(mref), "+v"(slope2));
    if (!RING) { WAIT_BAR(0); }
    const int wq0 = q0 + wid * 32;
    int tlo = T0, thi = T0 + NT - 1;
    if (KIND == 0) { int a = wq0 - 127; a = a < 0 ? 0 : a; tlo = a >> 6; thi = (wq0 + 31) >> 6; }
    if (KIND == 1) { thi = (wq0 + 31) >> 6; }
    u32x4 pw[4];
    auto QKI = [&](f32x16& p0, f32x16& p1, int t) {
        const int tile = T0 + NT - 1 - t, s = RING ? (t & 3) : ((t + dsc.s0) & 1); const ALAS unsigned char* kp = lds + LDS_K + s * SLOT + hi * 1024 + r32 * 16;
            const int kb0 = tile * 64 + 4 * hi;
            if (KIND == 1) { const ALAS f32x4* cs4 = (const ALAS f32x4*)(lds + LDS_C + s * 256); const float cm = csq - mref;
#pragma unroll
                for (int gg = 0; gg < 4; ++gg) { const f32x4 c0 = cs4[2 * gg + hi], c1 = cs4[8 + 2 * gg + hi];
#pragma unroll
                    for (int j = 0; j < 4; ++j) { p0[4 * gg + j] = cm - c0[j]; p1[4 * gg + j] = cm - c1[j]; } } }
            else if (KIND == 0) { const float base = -slope2 * (float)(qabs - kb0) - mref, s32 = 32.f * slope2;
#pragma unroll
                for (int gg = 0; gg < 4; ++gg) { const float bg = __builtin_fmaf(slope2, (float)(8 * gg), base);
#pragma unroll
                    for (int j = 0; j < 4; ++j) { const float v = __builtin_fmaf(slope2, (float)j, bg); p0[4 * gg + j] = v; p1[4 * gg + j] = v + s32; } } }
            else {
#pragma unroll
                for (int r = 0; r < 16; ++r) { p0[r] = -mref; p1[r] = -mref; } }
            __builtin_amdgcn_sched_barrier(0);
    };
    auto QKM = [&](f32x16& p0, f32x16& p1, int t) {
        const int s = RING ? (t & 3) : ((t + dsc.s0) & 1); const ALAS unsigned char* kp = lds + LDS_K + s * SLOT + hi * 1024 + r32 * 16;
#pragma unroll
        for (int hb = 0; hb < ND / 2; ++hb) {
            bf16x8 kf[4];
#pragma unroll
            for (int d0 = 0; d0 < 2; ++d0) { kf[2 * d0] = *(const ALAS bf16x8*)(kp + (2 * hb + d0) * 2048); kf[2 * d0 + 1] = *(const ALAS bf16x8*)(kp + (2 * hb + d0) * 2048 + 512); }
#pragma unroll
            for (int d0 = 0; d0 < 2; ++d0) { p0 = __builtin_amdgcn_mfma_f32_32x32x16_bf16(kf[2 * d0], qr[2 * hb + d0], p0, 0, 0, 0); p1 = __builtin_amdgcn_mfma_f32_32x32x16_bf16(kf[2 * d0 + 1], qr[2 * hb + d0], p1, 0, 0, 0); }
        }
    };
    auto POST = [&](f32x16& p0, f32x16& p1, int t) -> bool {
        const int tile = T0 + NT - 1 - t; const int kb0 = tile * 64 + 4 * hi;
            if (KIND == 1) { if (tile * 64 + 63 > wq0) {
#pragma unroll
                for (int r = 0; r < 16; ++r) { const int kv = kb0 + (r & 3) + 8 * (r >> 2); if (kv > qabs) p0[r] = -INFINITY; if (kv + 32 > qabs) p1[r] = -INFINITY; } } }
            if (KIND == 0) {
#pragma unroll
                for (int r = 0; r < 16; ++r) { const int rel = qabs - (kb0 + (r & 3) + 8 * (r >> 2)); if (rel < 0 || rel >= 128) p0[r] = -INFINITY; if (rel - 32 < 0 || rel - 32 >= 128) p1[r] = -INFINITY; } }
            const float rm = rowmax(p0, p1);
            if (KIND == 1 && started && __all(rm < -40.f)) return true;
            if (!started || __any(rm > THR)) {
                const float dl = started ? __builtin_fmaxf(rm, 0.f) : (rm > -1e30f ? rm : 0.f);
                mref += dl;
#pragma unroll
                for (int r = 0; r < 16; ++r) { p0[r] -= dl; p1[r] -= dl; }
                if (started) {
                    if (hi == 0) wsf[r32] = __builtin_amdgcn_exp2f(-dl);
                    f32x4 a4[4];
#pragma unroll
                    for (int gg = 0; gg < 4; ++gg) a4[gg] = *(const ALAS f32x4*)(wsf + 8 * gg + 4 * hi);
#pragma unroll
                    for (int r = 0; r < 16; ++r) lacc[r] *= a4[r >> 2][r & 3];
#pragma unroll
                    for (int d = 0; d < NO; ++d)
#pragma unroll
                        for (int r = 0; r < 16; ++r) o[d][r] *= a4[r >> 2][r & 3]; }
                started = true; }
        return false;
    };
    auto EXPP = [&](f32x16& p0, f32x16& p1) {
#pragma unroll
            for (int r = 0; r < 16; ++r) { p0[r] = __builtin_amdgcn_exp2f(p0[r]); p1[r] = __builtin_amdgcn_exp2f(p1[r]); }
            pw[0] = (u32x4){cvtpk(p0[0], p0[1]), cvtpk(p0[2], p0[3]), cvtpk(p0[4], p0[5]), cvtpk(p0[6], p0[7])}; pw[1] = (u32x4){cvtpk(p0[8], p0[9]), cvtpk(p0[10], p0[11]), cvtpk(p0[12], p0[13]), cvtpk(p0[14], p0[15])};
            pw[2] = (u32x4){cvtpk(p1[0], p1[1]), cvtpk(p1[2], p1[3]), cvtpk(p1[4], p1[5]), cvtpk(p1[6], p1[7])}; pw[3] = (u32x4){cvtpk(p1[8], p1[9]), cvtpk(p1[10], p1[11]), cvtpk(p1[12], p1[13]), cvtpk(p1[14], p1[15])};
    };
    auto PV = [&](int t) {
        const int s = RING ? (t & 3) : ((t + dsc.s0) & 1);
            const ALAS unsigned char* vp = lds + LDS_V + s * SLOT + vbl;
            s16x4 vlo[8], vhi[8];
            __builtin_amdgcn_sched_barrier(0);
#pragma unroll
            for (int i = 0; i < 4; ++i) { vlo[i] = vtr(vp + (i >> 2) * 4096 + (i & 3) * 1024); vhi[i] = vtr(vp + (i >> 2) * 4096 + (i & 3) * 1024 + 512); }
            __builtin_amdgcn_sched_barrier(0);
            __builtin_amdgcn_sched_barrier(0);
#pragma unroll
            for (int i = 4; i < 8; ++i) { vlo[i] = vtr(vp + (i >> 2) * 4096 + (i & 3) * 1024); vhi[i] = vtr(vp + (i >> 2) * 4096 + (i & 3) * 1024 + 512); }
#pragma unroll
            for (int ks = 0; ks < 4; ++ks) lacc = __builtin_amdgcn_mfma_f32_32x32x16_bf16(__builtin_bit_cast(bf16x8, pw[ks]), ones, lacc, 0, 0, 0);
#pragma unroll
            for (int i = 0; i < 8; ++i) { const bf16x8 vf = (bf16x8){vlo[i][0], vlo[i][1], vlo[i][2], vlo[i][3], vhi[i][0], vhi[i][1], vhi[i][2], vhi[i][3]};
                o[i >> 2] = __builtin_amdgcn_mfma_f32_32x32x16_bf16(__builtin_bit_cast(bf16x8, pw[i & 3]), vf, o[i >> 2], 0, 0, 0); }
            if (NO > 2) {
#pragma unroll
                for (int i = 0; i < 8; ++i) { vlo[i] = vtr(vp + (2 + (i >> 2)) * 4096 + (i & 3) * 1024); vhi[i] = vtr(vp + (2 + (i >> 2)) * 4096 + (i & 3) * 1024 + 512); }
#pragma unroll
                for (int i = 0; i < 8; ++i) { const bf16x8 vf = (bf16x8){vlo[i][0], vlo[i][1], vlo[i][2], vlo[i][3], vhi[i][0], vhi[i][1], vhi[i][2], vhi[i][3]};
                    o[(NO > 2 ? 2 : 0) + (i >> 2)] = __builtin_amdgcn_mfma_f32_32x32x16_bf16(__builtin_bit_cast(bf16x8, pw[i & 3]), vf, o[(NO > 2 ? 2 : 0) + (i >> 2)], 0, 0, 0); } }
    };
    auto BOTH = [&](f32x16& n0, f32x16& n1, f32x16& c0, f32x16& c1, int tn) {
        const ALAS unsigned char* kp = lds + LDS_K + (tn & 3) * SLOT + hi * 1024 + r32 * 16;
        bf16x8 ka = *(const ALAS bf16x8*)(kp), kb = *(const ALAS bf16x8*)(kp + 512);
#pragma unroll
        for (int d0 = 0; d0 < 4; ++d0) {
            n0 = __builtin_amdgcn_mfma_f32_32x32x16_bf16(ka, qr[d0], n0, 0, 0, 0);
            if (d0 < 3) ka = *(const ALAS bf16x8*)(kp + (d0 + 1) * 2048);
#pragma unroll
            for (int r = 4 * d0; r < 4 * d0 + 4; ++r) c0[r] = __builtin_amdgcn_exp2f(c0[r]);
            { const unsigned a = cvtpk(c0[4 * d0], c0[4 * d0 + 1]), b = cvtpk(c0[4 * d0 + 2], c0[4 * d0 + 3]); if (d0 & 1) { pw[d0 >> 1].z = a; pw[d0 >> 1].w = b; } else { pw[d0 >> 1].x = a; pw[d0 >> 1].y = b; } }
            n1 = __builtin_amdgcn_mfma_f32_32x32x16_bf16(kb, qr[d0], n1, 0, 0, 0);
            if (d0 < 3) kb = *(const ALAS bf16x8*)(kp + (d0 + 1) * 2048 + 512);
#pragma unroll
            for (int r = 4 * d0; r < 4 * d0 + 4; ++r) c1[r] = __builtin_amdgcn_exp2f(c1[r]);
            { const unsigned a = cvtpk(c1[4 * d0], c1[4 * d0 + 1]), b = cvtpk(c1[4 * d0 + 2], c1[4 * d0 + 3]); if (d0 & 1) { pw[2 + (d0 >> 1)].z = a; pw[2 + (d0 >> 1)].w = b; } else { pw[2 + (d0 >> 1)].x = a; pw[2 + (d0 >> 1)].y = b; } }
        }
    };
    const int ta = (T0 + NT - 1) - thi, tb = (T0 + NT - 1) - tlo;
    bool pub = false;
    if (B128 && KIND != 2) {
        int NPR = NT / 2; const int last = T0 + NT - 1;
#if defined(PROBE_REPEAT)
        if (T.pflag && (PROBE_REPEAT == 61 || PROBE_REPEAT == 63)) NPR = 0;
#endif
        f32x16 pL0, pL1, pH0, pH1; u32x4 pw[8];
        for (int t = 0; t < NPR; ++t) {
            const int s = (t + dsc.s0) & 1, tl = last - 2 * t - 1;
            const bool lastst = (EARLY_HEAD & 1) && (t == NPR - 1) && (NPR >= 2);
            if (t == 0) LGKM_BAR();
            else if (lastst) { asm volatile("s_waitcnt vmcnt(0)" ::: "memory"); if (tid == 0) misc[24] = qnext + T.q_lo; LGKM_BAR(); }
            else WAIT_BAR(0);
            if (t >= 1 && t + 1 < NPR) issue_pair(g, KIND, last, t + 1, (t + 1 + dsc.s0) & 1, lds0, wid, lane);
            if (lastst) { next_u = __builtin_amdgcn_readfirstlane((int)misc[24]); pub = true;
                if (next_u < n_total) { nd = decode(PROBE_MAP(next_u), T.t0tab); nd.s0 = (t + 1 + dsc.s0) & 1; nd.early = 1; const Geo ng = geo(T, nd); if (!(EARLY_HEAD & 4)) issue_head(T, ng, nd, lds0, wid, lane); } }
            if (tl <= thi && tl + 1 >= tlo) {
                const ALAS unsigned char* kpL = lds + LDS_K + s * 16384 + hi * 1024 + r32 * 16; const ALAS unsigned char* kpH = kpL + 8192;
                const int kbL = tl * 64 + 4 * hi, kbH = kbL + 64;
                if (KIND == 0) { const float base = -slope2 * (float)(qabs - kbL) - mref, s32 = 32.f * slope2, s64 = 64.f * slope2;
#pragma unroll
                    for (int gg = 0; gg < 4; ++gg) { const float bg = __builtin_fmaf(slope2, (float)(8 * gg), base);
#pragma unroll
                        for (int j = 0; j < 4; ++j) { const float v = __builtin_fmaf(slope2, (float)j, bg); pL0[4 * gg + j] = v; pL1[4 * gg + j] = v + s32; pH0[4 * gg + j] = v + s64; pH1[4 * gg + j] = v + s64 + s32; } } }
                else { const ALAS f32x4* cs4 = (const ALAS f32x4*)(lds + LDS_C + s * 512); const float cm = csq - mref;
#pragma unroll
                  for (int gg = 0; gg < 4; ++gg) { const f32x4 a0 = cs4[2 * gg + hi], a1 = cs4[8 + 2 * gg + hi], b0 = cs4[16 + 2 * gg + hi], b1 = cs4[24 + 2 * gg + hi];
#pragma unroll
                      for (int j = 0; j < 4; ++j) { pL0[4 * gg + j] = cm - a0[j]; pL1[4 * gg + j] = cm - a1[j]; pH0[4 * gg + j] = cm - b0[j]; pH1[4 * gg + j] = cm - b1[j]; } } }
#if QK_SPLIT
                float rmL;
                { bf16x8 ka = *(const ALAS bf16x8*)(kpL), kb = *(const ALAS bf16x8*)(kpL + 512), kc = *(const ALAS bf16x8*)(kpH), kd = *(const ALAS bf16x8*)(kpH + 512);
#pragma unroll
                  for (int d0 = 0; d0 < 4; ++d0) {
                      pL0 = __builtin_amdgcn_mfma_f32_32x32x16_bf16(ka, qr[d0], pL0, 0, 0, 0); if (d0 < 3) ka = *(const ALAS bf16x8*)(kpL + (d0 + 1) * 2048);
                      pL1 = __builtin_amdgcn_mfma_f32_32x32x16_bf16(kb, qr[d0], pL1, 0, 0, 0); if (d0 < 3) kb = *(const ALAS bf16x8*)(kpL + (d0 + 1) * 2048 + 512); }
                  __builtin_amdgcn_sched_barrier(0);
#pragma unroll
                  for (int d0 = 0; d0 < 4; ++d0) {
                      pH0 = __builtin_amdgcn_mfma_f32_32x32x16_bf16(kc, qr[d0], pH0, 0, 0, 0); if (d0 < 3) kc = *(const ALAS bf16x8*)(kpH + (d0 + 1) * 2048);
                      pH1 = __builtin_amdgcn_mfma_f32_32x32x16_bf16(kd, qr[d0], pH1, 0, 0, 0); if (d0 < 3) kd = *(const ALAS bf16x8*)(kpH + (d0 + 1) * 2048 + 512); }
                  if (KIND == 0) {
#pragma unroll
                      for (int r = 0; r < 16; ++r) { const int rel = qabs - (kbL + (r & 3) + 8 * (r >> 2)); if ((unsigned)rel >= 128u) pL0[r] = -INFINITY; if ((unsigned)(rel - 32) >= 128u) pL1[r] = -INFINITY; } }
                  else if ((tl + 1) * 64 + 63 > wq0) {
#pragma unroll
                      for (int r = 0; r < 16; ++r) { const int kv = kbL + (r & 3) + 8 * (r >> 2); if (kv > qabs) pL0[r] = -INFINITY; if (kv + 32 > qabs) pL1[r] = -INFINITY; } }
                  rmL = rowmax(pL0, pL1);
#pragma unroll
                  for (int q = 0; q < 8; ++q) { __builtin_amdgcn_sched_group_barrier(0x8, 1, 0); __builtin_amdgcn_sched_group_barrier(0x2, 4, 0); }
                  __builtin_amdgcn_sched_barrier(0); }
                if (KIND == 0) {
#pragma unroll
                    for (int r = 0; r < 16; ++r) { const int rel = qabs - (kbL + (r & 3) + 8 * (r >> 2)); if ((unsigned)(rel - 64) >= 128u) pH0[r] = -INFINITY; if ((unsigned)(rel - 96) >= 128u) pH1[r] = -INFINITY; } }
                else if ((tl + 1) * 64 + 63 > wq0) {
#pragma unroll
                    for (int r = 0; r < 16; ++r) { const int kv = kbL + (r & 3) + 8 * (r >> 2); if (kv + 64 > qabs) pH0[r] = -INFINITY; if (kv + 96 > qabs) pH1[r] = -INFINITY; } }
                (void)kbH;
                const float rm = __builtin_fmaxf(rmL, rowmax(pH0, pH1));
#else
                { bf16x8 ka = *(const ALAS bf16x8*)(kpL), kb = *(const ALAS bf16x8*)(kpL + 512), kc = *(const ALAS bf16x8*)(kpH), kd = *(const ALAS bf16x8*)(kpH + 512);
#pragma unroll
                  for (int d0 = 0; d0 < 4; ++d0) {
                      pL0 = __builtin_amdgcn_mfma_f32_32x32x16_bf16(ka, qr[d0], pL0, 0, 0, 0); if (d0 < 3) ka = *(const ALAS bf16x8*)(kpL + (d0 + 1) * 2048);
                      pL1 = __builtin_amdgcn_mfma_f32_32x32x16_bf16(kb, qr[d0], pL1, 0, 0, 0); if (d0 < 3) kb = *(const ALAS bf16x8*)(kpL + (d0 + 1) * 2048 + 512);
                      pH0 = __builtin_amdgcn_mfma_f32_32x32x16_bf16(kc, qr[d0], pH0, 0, 0, 0); if (d0 < 3) kc = *(const ALAS bf16x8*)(kpH + (d0 + 1) * 2048);
                      pH1 = __builtin_amdgcn_mfma_f32_32x32x16_bf16(kd, qr[d0], pH1, 0, 0, 0); if (d0 < 3) kd = *(const ALAS bf16x8*)(kpH + (d0 + 1) * 2048 + 512); } }
                if (KIND == 0) {
#pragma unroll
                    for (int r = 0; r < 16; ++r) { const int rel = qabs - (kbL + (r & 3) + 8 * (r >> 2));
                        if ((unsigned)rel >= 128u) pL0[r] = -INFINITY; if ((unsigned)(rel - 32) >= 128u) pL1[r] = -INFINITY; if ((unsigned)(rel - 64) >= 128u) pH0[r] = -INFINITY; if ((unsigned)(rel - 96) >= 128u) pH1[r] = -INFINITY; } }
                else if ((tl + 1) * 64 + 63 > wq0) {
#pragma unroll
                    for (int r = 0; r < 16; ++r) { const int kv = kbL + (r & 3) + 8 * (r >> 2);
                        if (kv > qabs) pL0[r] = -INFINITY; if (kv + 32 > qabs) pL1[r] = -INFINITY; if (kv + 64 > qabs) pH0[r] = -INFINITY; if (kv + 96 > qabs) pH1[r] = -INFINITY; } }
                (void)kbH;
                const float rm = __builtin_fmaxf(rowmax(pL0, pL1), rowmax(pH0, pH1));
#endif
                bool negl = false;
                if (KIND == 1 && started && __all(rm < -40.f)) negl = true;
                if (!negl) {
                if (!started || __any(rm > THR)) {
                    const float dl = started ? __builtin_fmaxf(rm, 0.f) : (rm > -1e30f ? rm : 0.f);
                    mref += dl;
#pragma unroll
                    for (int r = 0; r < 16; ++r) { pL0[r] -= dl; pL1[r] -= dl; pH0[r] -= dl; pH1[r] -= dl; }
                    if (started) {
                        if (hi == 0) wsf[r32] = __builtin_amdgcn_exp2f(-dl);
                        f32x4 a4[4];
#pragma unroll
                        for (int gg = 0; gg < 4; ++gg) a4[gg] = *(const ALAS f32x4*)(wsf + 8 * gg + 4 * hi);
#pragma unroll
                        for (int r = 0; r < 16; ++r) lacc[r] *= a4[r >> 2][r & 3];
#pragma unroll
                        for (int d = 0; d < NO; ++d)
#pragma unroll
                            for (int r = 0; r < 16; ++r) o[d][r] *= a4[r >> 2][r & 3]; }
                    started = true; }
                const ALAS unsigned char* vpL = lds + LDS_V + s * 16384 + vbl; const ALAS unsigned char* vpH = vpL + 8192;
                s16x4 vl[8], vh[8], wl[8], wh[8];
                __builtin_amdgcn_sched_barrier(0);
#pragma unroll
                for (int i = 0; i < 8; ++i) { vl[i] = vtr(vpL + (i >> 2) * 4096 + (i & 3) * 1024); vh[i] = vtr(vpL + (i >> 2) * 4096 + (i & 3) * 1024 + 512); }
                __builtin_amdgcn_sched_barrier(0);
#if PV_INTERLEAVE
#define EXPPACK_(P, k0) do { _Pragma("unroll") for (int r = 0; r < 16; ++r) P[r] = __builtin_amdgcn_exp2f(P[r]); \
                    pw[k0] = (u32x4){cvtpk(P[0], P[1]), cvtpk(P[2], P[3]), cvtpk(P[4], P[5]), cvtpk(P[6], P[7])}; pw[k0 + 1] = (u32x4){cvtpk(P[8], P[9]), cvtpk(P[10], P[11]), cvtpk(P[12], P[13]), cvtpk(P[14], P[15])}; } while (0)
#define VF_(a, b, i) ((bf16x8){a[i][0], a[i][1], a[i][2], a[i][3], b[i][0], b[i][1], b[i][2], b[i][3]})
#define MM_(kw, a, b, kk) do { lacc = __builtin_amdgcn_mfma_f32_32x32x16_bf16(__builtin_bit_cast(bf16x8, pw[kw]), ones, lacc, 0, 0, 0); \
                    o[0] = __builtin_amdgcn_mfma_f32_32x32x16_bf16(__builtin_bit_cast(bf16x8, pw[kw]), VF_(a, b, kk), o[0], 0, 0, 0); o[1] = __builtin_amdgcn_mfma_f32_32x32x16_bf16(__builtin_bit_cast(bf16x8, pw[kw]), VF_(a, b, 4 + kk), o[1], 0, 0, 0); } while (0)
#define ILV_() do { _Pragma("unroll") for (int q = 0; q < 6; ++q) { __builtin_amdgcn_sched_group_barrier(0x8, 1, 0); __builtin_amdgcn_sched_group_barrier(0x2, 4, 0); } } while (0)
                EXPPACK_(pL0, 0);
                __builtin_amdgcn_sched_barrier(0);
                MM_(0, vl, vh, 0); MM_(1, vl, vh, 1); EXPPACK_(pL1, 2); ILV_();
                __builtin_amdgcn_sched_barrier(0);
#pragma unroll
                for (int i = 0; i < 8; ++i) { wl[i] = vtr(vpH + (i >> 2) * 4096 + (i & 3) * 1024); wh[i] = vtr(vpH + (i >> 2) * 4096 + (i & 3) * 1024 + 512); }
                MM_(2, vl, vh, 2); MM_(3, vl, vh, 3); EXPPACK_(pH0, 4); ILV_();
                __builtin_amdgcn_sched_barrier(0);
                MM_(4, wl, wh, 0); MM_(5, wl, wh, 1); EXPPACK_(pH1, 6); ILV_();
                __builtin_amdgcn_sched_barrier(0);
                MM_(6, wl, wh, 2); MM_(7, wl, wh, 3);
#undef EXPPACK_
#undef VF_
#undef MM_
#undef ILV_
#else
#pragma unroll
                for (int r = 0; r < 16; ++r) { pL0[r] = __builtin_amdgcn_exp2f(pL0[r]); pL1[r] = __builtin_amdgcn_exp2f(pL1[r]); pH0[r] = __builtin_amdgcn_exp2f(pH0[r]); pH1[r] = __builtin_amdgcn_exp2f(pH1[r]); }
                pw[0] = (u32x4){cvtpk(pL0[0], pL0[1]), cvtpk(pL0[2], pL0[3]), cvtpk(pL0[4], pL0[5]), cvtpk(pL0[6], pL0[7])}; pw[1] = (u32x4){cvtpk(pL0[8], pL0[9]), cvtpk(pL0[10], pL0[11]), cvtpk(pL0[12], pL0[13]), cvtpk(pL0[14], pL0[15])};
                pw[2] = (u32x4){cvtpk(pL1[0], pL1[1]), cvtpk(pL1[2], pL1[3]), cvtpk(pL1[4], pL1[5]), cvtpk(pL1[6], pL1[7])}; pw[3] = (u32x4){cvtpk(pL1[8], pL1[9]), cvtpk(pL1[10], pL1[11]), cvtpk(pL1[12], pL1[13]), cvtpk(pL1[14], pL1[15])};
                pw[4] = (u32x4){cvtpk(pH0[0], pH0[1]), cvtpk(pH0[2], pH0[3]), cvtpk(pH0[4], pH0[5]), cvtpk(pH0[6], pH0[7])}; pw[5] = (u32x4){cvtpk(pH0[8], pH0[9]), cvtpk(pH0[10], pH0[11]), cvtpk(pH0[12], pH0[13]), cvtpk(pH0[14], pH0[15])};
                pw[6] = (u32x4){cvtpk(pH1[0], pH1[1]), cvtpk(pH1[2], pH1[3]), cvtpk(pH1[4], pH1[5]), cvtpk(pH1[6], pH1[7])}; pw[7] = (u32x4){cvtpk(pH1[8], pH1[9]), cvtpk(pH1[10], pH1[11]), cvtpk(pH1[12], pH1[13]), cvtpk(pH1[14], pH1[15])};
                __builtin_amdgcn_sched_barrier(0);
#pragma unroll
                for (int i = 0; i < 8; ++i) { wl[i] = vtr(vpH + (i >> 2) * 4096 + (i & 3) * 1024); wh[i] = vtr(vpH + (i >> 2) * 4096 + (i & 3) * 1024 + 512); }
#pragma unroll
                for (int k = 0; k < 8; ++k) lacc = __builtin_amdgcn_mfma_f32_32x32x16_bf16(__builtin_bit_cast(bf16x8, pw[k]), ones, lacc, 0, 0, 0);
#pragma unroll
                for (int i = 0; i < 8; ++i) { const bf16x8 vf = (bf16x8){vl[i][0], vl[i][1], vl[i][2], vl[i][3], vh[i][0], vh[i][1], vh[i][2], vh[i][3]};
                    o[i >> 2] = __builtin_amdgcn_mfma_f32_32x32x16_bf16(__builtin_bit_cast(bf16x8, pw[i & 3]), vf, o[i >> 2], 0, 0, 0); }
#pragma unroll
                for (int i = 0; i < 8; ++i) { const bf16x8 vf = (bf16x8){wl[i][0], wl[i][1], wl[i][2], wl[i][3], wh[i][0], wh[i][1], wh[i][2], wh[i][3]};
                    o[i >> 2] = __builtin_amdgcn_mfma_f32_32x32x16_bf16(__builtin_bit_cast(bf16x8, pw[4 + (i & 3)]), vf, o[i >> 2], 0, 0, 0); }
#endif
                }
            }
        }
    } else {
    constexpr bool PIPE = (KIND == 1);
    if (PIPE) {
        f32x16 pA0, pA1, pB0, pB1;
        bool skA = false, skB = false;
        auto STEP = [&](f32x16& c0, f32x16& c1, bool& skc, f32x16& n0, f32x16& n1, bool& skn, int t) {
            { const int li = (t < 0) ? 2 : (t == 0 ? 3 : t + 2); int nbh = (li < NT - 1 ? li : NT - 1) - (t + 1); if (nbh < 0) nbh = 0;
#if defined(PROBE_REPEAT)
              if (PROBE_REPEAT == 14 && dsc.dummy) { LGKM_BAR(); } else
#endif
              if (KIND == 1 && wid == 0) { if (nbh >= 2) WAIT_BAR(6); else if (nbh == 1) WAIT_BAR(3); else WAIT_BAR(0); }
              else { if (nbh >= 2) WAIT_BAR(4); else if (nbh == 1) WAIT_BAR(2); else WAIT_BAR(0); } }
            if (t < 0) { if (3 < NT) issue_tile(g, KIND, T0 + NT - 1 - 3, 3, lds0, wid, lane); }
            else if (t >= 1) { if (t + 3 < NT) issue_tile(g, KIND, T0 + NT - 1 - (t + 3), (t + 3) & 3, lds0, wid, lane); }
            const bool an = (t + 1 >= ta) && (t + 1 <= tb) && (t + 1 < NT), ac = (t >= ta) && (t <= tb) && (t >= 0) && !skc;
            if (ABL == 43) return;
            if (an && ABL != 44) QKI(n0, n1, t + 1);
            if (ABL == 41) { if (ac) EXPP(c0, c1); } else if (ABL == 45) { if (an) QKM(n0, n1, t + 1); } else { if (an && ac) BOTH(n0, n1, c0, c1, t + 1); else if (an) QKM(n0, n1, t + 1); else if (ac) EXPP(c0, c1); }
            if (ac && ABL != 40) PV(t);
            skn = false; if (an && ABL != 42) skn = POST(n0, n1, t + 1);
        };
        STEP(pB0, pB1, skB, pA0, pA1, skA, -1);
        for (int t = 0; t < NT; t += 2) {
            STEP(pA0, pA1, skA, pB0, pB1, skB, t);
            if (t + 1 < NT) STEP(pB0, pB1, skB, pA0, pA1, skA, t + 1);
        }
    } else if (RING) {
        f32x16 p0, p1;
        for (int t = 0; t < NT; ++t) {
            const int rem = NT - 1 - t;
            if (rem >= 2) WAIT_BAR(4); else if (rem == 1) WAIT_BAR(2); else WAIT_BAR(0);
            if (t + 3 < NT) issue_tile(g, KIND, T0 + NT - 1 - (t + 3), (t + 3) & 3, lds0, wid, lane);
            if (t >= ta && t <= tb) { QKI(p0, p1, t); QKM(p0, p1, t); (void)POST(p0, p1, t); EXPP(p0, p1); PV(t); }
        }
    } else {
        f32x16 p0, p1;
        for (int t = 0; t < NT; ++t) {
            if (t + 1 < NT) issue_tile(g, KIND, T0 + NT - 1 - (t + 1), (t + 1 + dsc.s0) & 1, lds0, wid, lane);
            else if (pub && next_u < n_total) { nd = decode(PROBE_MAP(next_u), T.t0tab); nd.s0 = (t + 1 + dsc.s0) & 1; nd.early = 1; const Geo ng = geo(T, nd); issue_head(T, ng, nd, lds0, wid, lane); }
            QKI(p0, p1, t); QKM(p0, p1, t); (void)POST(p0, p1, t); EXPP(p0, p1); PV(t);
            if ((EARLY_HEAD & 2) && t + 2 == NT) { asm volatile("s_waitcnt vmcnt(0)" ::: "memory"); if (tid == 0) misc[24] = qnext + T.q_lo; LGKM_BAR(); next_u = __builtin_amdgcn_readfirstlane((int)misc[24]); pub = true; }
            else if (t + 1 < NT) WAIT_BAR(0);
        }
    }
    }
    (void)nidx;
    if (!pub) { asm volatile("s_waitcnt vmcnt(0)" ::: "memory"); if (tid == 0) misc[24] = qnext + T.q_lo; }
    LGKM_BAR();
    if (!pub) next_u = __builtin_amdgcn_readfirstlane((int)misc[24]);
    if (next_u < n_total) {
        if (!pub) { nd = decode(PROBE_MAP(next_u), T.t0tab); nd.s0 = 0; nd.early = 0; }
        const Geo ng = geo(T, nd);
        if (!pub || (EARLY_HEAD & 4)) issue_head(T, ng, nd, lds0, wid, lane);
        issue_rest(ng, nd, lds0, wid, lane);
#if defined(PROBE_REPEAT) && (PROBE_REPEAT != -1)
        nd.after = 0;
#else
        nd.after = ((nd.kind != 2 && nd.NT > 2) ? 4 + ((nd.kind == 1 && wid == 0) ? 2 : 0) : 0) + ((KIND == 2) ? 8 : 4);
#endif
    }
#if defined(PROBE_REPEAT)
    if (T.pflag && (PROBE_REPEAT == 62 || PROBE_REPEAT == 63)) return;
#endif
    float rli[16];
#pragma unroll
    for (int r = 0; r < 16; ++r) rli[r] = __builtin_amdgcn_rcpf(lacc[r]);
    ALAS unsigned short* stg = (ALAS unsigned short*)(lds + LDS_OST) + wid * 2048;
    unsigned short* urow = (dsc.dummy ? T.U2() : T.U()) + (rowbase + q0 + wid * 32) * DM + ucol;
    u32x4 zq[NO / 2][4];
#pragma unroll
    for (int pass = 0; pass < NO / 2; ++pass)
#pragma unroll
        for (int i = 0; i < 4; ++i) { if (KIND != 2) zq[pass][i] = *(const ALAS u32x4*)(stg + (i * 8 + (lane >> 3)) * 64 + (lane & 7) * 8);
                                      else zq[pass][i] = *(const u32x4*)(zrow + (size_t)(i * 8 + (lane >> 3)) * qzp + pass * 64 + (lane & 7) * 8); }
    if (KIND != 2) asm volatile("s_waitcnt lgkmcnt(0)" ::: "memory");
    __builtin_amdgcn_sched_barrier(0);
#if defined(PROBE_REPEAT)
    if (T.pflag && PROBE_REPEAT == 66) { asm volatile("" :: "v"(zq[0][0]), "v"(zq[0][3]), "v"(rli[0]), "v"(rli[15])); return; }
#endif
#pragma unroll
    for (int pass = 0; pass < NO / 2; ++pass) {
#pragma unroll
        for (int r = 0; r < 16; ++r) { const int orow = crow(r, hi);
#pragma unroll
            for (int d = 0; d < 2; ++d) stg[orow * 64 + d * 32 + r32] = (unsigned short)(cvtpk(o[pass * 2 + d][r] * rli[r], 0.f) & 0xffffu); }
#pragma unroll
        for (int i = 0; i < 4; ++i) { const int row = i * 8 + (lane >> 3), ch = lane & 7;
            const u32x4 ov = *(const ALAS u32x4*)(stg + row * 64 + ch * 8); const u32x4 zv = zq[pass][i];
            u32x4 w;
            w.x = cvtpk(__uint_as_float(ov.x << 16) * __uint_as_float(zv.x << 16), __uint_as_float(ov.x & 0xffff0000u) * __uint_as_float(zv.x & 0xffff0000u));
            w.y = cvtpk(__uint_as_float(ov.y << 16) * __uint_as_float(zv.y << 16), __uint_as_float(ov.y & 0xffff0000u) * __uint_as_float(zv.y & 0xffff0000u));
            w.z = cvtpk(__uint_as_float(ov.z << 16) * __uint_as_float(zv.z << 16), __uint_as_float(ov.z & 0xffff0000u) * __uint_as_float(zv.z & 0xffff0000u));
            w.w = cvtpk(__uint_as_float(ov.w << 16) * __uint_as_float(zv.w << 16), __uint_as_float(ov.w & 0xffff0000u) * __uint_as_float(zv.w & 0xffff0000u));
#if defined(PROBE_REPEAT)
            if (T.pflag && PROBE_REPEAT == 65) { asm volatile("" :: "v"(w)); } else
#endif
            *(u32x4*)(urow + (size_t)row * DM + pass * 64 + ch * 8) = w; }
    }
}
#undef MX3
#undef WAIT_BAR
#undef LGKM_BAR
#undef ALAS
}

#ifndef PROBE_REPEAT
#define PROBE_REPEAT (-1)
#endif
#ifndef STATIC_FIRST
#define STATIC_FIRST 1
#endif
#ifndef FB_UNROLL
#define FB_UNROLL 3
#endif
#ifndef TLB_TOUCH
#define TLB_TOUCH 0
#endif
#ifndef P0_SWAP
#define P0_SWAP 0
#endif
#ifndef WS_TOP
#define WS_TOP 1
#endif
#ifndef P0_NT
#define P0_NT 1
#endif
#ifndef W1T_IN_OUT
#define W1T_IN_OUT 0
#endif
#ifndef WS_SLACK
#define WS_SLACK (4 * MiB)
#endif
#ifndef P1_MIX
#define P1_MIX 2
#endif
#ifndef P34_WGM
#define P34_WGM 4
#endif
#ifndef PROBE_WIN_LO
#define PROBE_WIN_LO 0
#define PROBE_WIN_HI 0
#endif
#ifndef P1_ALIGN
#define P1_ALIGN true
#endif
#ifndef P1_SP2
#define P1_SP2 true
#endif
#ifndef P1_WGM
#define P1_WGM 8
#endif

struct Frame {
    LAS unsigned char* lds;
    volatile LAS unsigned* MISC;
    gu32* ctl;
    int tid, lane, wave;
    int vcu, G;
};
__device__ __forceinline__ float wave_sum_f(float v) {
#ifdef OLD_WSUM
    for (int o = 1; o < 64; o <<= 1) v += __shfl_xor(v, o);
    return v;
#endif
    v += __builtin_bit_cast(float, __builtin_amdgcn_update_dpp(0, __builtin_bit_cast(int, v), 0xB1, 0xf, 0xf, false));
    v += __builtin_bit_cast(float, __builtin_amdgcn_update_dpp(0, __builtin_bit_cast(int, v), 0x4E, 0xf, 0xf, false));
    v += __builtin_bit_cast(float, __builtin_amdgcn_update_dpp(0, __builtin_bit_cast(int, v), 0x141, 0xf, 0xf, false));
    v += __builtin_bit_cast(float, __builtin_amdgcn_update_dpp(0, __builtin_bit_cast(int, v), 0x140, 0xf, 0xf, false));
    v += __builtin_bit_cast(float, __builtin_amdgcn_update_dpp(0, __builtin_bit_cast(int, v), 0x142, 0xa, 0xf, false));
    v += __builtin_bit_cast(float, __builtin_amdgcn_update_dpp(0, __builtin_bit_cast(int, v), 0x143, 0xc, 0xf, false));
    v = __builtin_bit_cast(float, __builtin_amdgcn_readlane(__builtin_bit_cast(int, v), 63));
    return v;
}
__device__ __forceinline__ void p0_item_load(f32x4 (&v)[8], const float* Wsrc, int ldw, int lane) {
#pragma unroll
    for (int i = 0; i < 8; ++i) v[i] = P0_NT ? __builtin_nontemporal_load((const GAS f32x4*)(Wsrc + (size_t)(8 * i + (lane >> 3)) * ldw + 4 * (lane & 7))) : *(const GAS f32x4*)(Wsrc + (size_t)(8 * i + (lane >> 3)) * ldw + 4 * (lane & 7));
}
__device__ __forceinline__ void p0_item_finish(const f32x4 (&v)[8], bf16* dst, int ldd, LAS float* scr, int lane) {
#pragma unroll
    for (int i = 0; i < 8; ++i) { LAS float* d = scr + (8 * i + (lane >> 3)) * 33 + 4 * (lane & 7); d[0] = v[i].x; d[1] = v[i].y; d[2] = v[i].z; d[3] = v[i].w; }
    LDS_WAIT(); asm volatile("" ::: "memory");
    const int c = lane & 7;
#pragma unroll
    for (int j = 0; j < 4; ++j) { const int n = (lane >> 3) + 8 * j; const LAS float* s = scr + (8 * c) * 33 + n;
        v4u o; o.x = pk2(s[0 * 33], s[1 * 33]); o.y = pk2(s[2 * 33], s[3 * 33]); o.z = pk2(s[4 * 33], s[5 * 33]); o.w = pk2(s[6 * 33], s[7 * 33]);
        *(GAS v4u*)(dst + (size_t)n * ldd + 8 * c) = o; }
    LDS_WAIT(); asm volatile("" ::: "memory");
}
__device__ __forceinline__ void rms_row_load(f32x4 (&v)[8], const float* xrow, int lane) { const GAS f32x4* xr = (const GAS f32x4*)xrow + lane;
#pragma unroll
    for (int j = 0; j < 8; ++j) v[j] = P0_NT ? __builtin_nontemporal_load(xr + 64 * j) : xr[64 * j]; }
template <bool FB> __device__ __forceinline__ void rms_row(f32x4 (&v)[8], const f32x4 (&gn)[8], bf16* orow, int lane, const LAS f32x4* wfb4, float bias_lane  , float* lf_out  ) {
    float s = 0.f;
#pragma unroll
    for (int j = 0; j < 8; ++j) { s += (v[j].x * v[j].x + v[j].y * v[j].y) + (v[j].z * v[j].z + v[j].w * v[j].w); }
    const float rstd = 1.f / sqrtf(wave_sum_f(s) * (1.f / DM) + EPS);
    GAS unsigned long long* o8 = (GAS unsigned long long*)orow + lane;
#pragma unroll
    for (int j = 0; j < 8; ++j) { v[j] = v[j] * rstd * gn[j]; o8[64 * j] = (unsigned long long)pk2(v[j].x, v[j].y) | ((unsigned long long)pk2(v[j].z, v[j].w) << 32); }
    if constexpr (FB) {
        float mine = 0.f;
#pragma unroll FB_UNROLL
        for (int h = 0; h < 12; ++h) { float a = 0.f;
#pragma unroll
            for (int j = 0; j < 8; ++j) { const f32x4 w = wfb4[h * 512 + 64 * j + lane]; a += (v[j].x * w.x + v[j].y * w.y) + (v[j].z * w.z + v[j].w * w.w); }
            a = wave_sum_f(a); mine = (lane == h) ? a : mine; }
        if (lane < 12) lf_out[(size_t)lane * SEQ] = log_sigmoidf_(mine + bias_lane);
    }
}
struct Args { const float* in[18]; float* out; unsigned char* ws; int ph_lo, ph_hi, li, pad; };

__device__ __forceinline__ void p0_prologue(Frame& F, const Args& args) {
    unsigned char* ws = args.ws;
    const float* x = args.in[0]; const float* mem = args.in[1]; const float* norm_gain = args.in[2]; const float* mem_norm_gain = args.in[3]; const float* w_in = args.in[4]; const float* b_forget = args.in[5];
    const float* w_mem_kv = args.in[13]; const float* w_br_a = args.in[14]; const float* w_br_b = args.in[15]; const float* w_br_c = args.in[16]; const float* w_out = args.in[17];
    bf16* HN = (bf16*)(ws + WS_HN); bf16* MEMN = (bf16*)(ws + WS_MEMN); float* LF = (float*)(ws + WS_LF);
    bf16* W1T = W1T_IN_OUT ? (bf16*)args.out : (bf16*)(ws + WS_W1T); bf16* WMKVT = (bf16*)(ws + WS_WMKVT); bf16* WBRT = (bf16*)(ws + WS_WBRT); bf16* WOUTT = (bf16*)(ws + WS_WOUTT);
    const int NPROD = (F.G > 16) ? 8 : 0; gu32* p0c = F.ctl + CW_P0MK;
    if ((int)blockIdx.x < NPROD) {
        if (((PROBE_REPEAT >= 71 && PROBE_REPEAT <= 76) || PROBE_REPEAT == 81 || (PROBE_REPEAT >= 90 && PROBE_REPEAT <= 93)) && args.pad) return;
        if (F.tid == 0) { unsigned sp = 0; while (__hip_atomic_load((unsigned*)p0c, __ATOMIC_RELAXED, __HIP_MEMORY_SCOPE_AGENT) < (unsigned)(F.G - NPROD)) { __builtin_amdgcn_s_sleep(8); if (++sp > (1u << 22)) break; }
            __builtin_amdgcn_fence(__ATOMIC_ACQUIRE, "agent"); VM_WAIT(); }
        __syncthreads();
        const int u = (int)blockIdx.x; bf16* MKV = (bf16*)(ws + WS_MKV);
        pg8::Gemm g{MEMN, WMKVT, MM, 1024, DM}; pg8::SingleOrder S{u >> 2, u & 3}; pg8::EpiMkv E{MKV, MKV + 262144, args.in[12], EPS};
        pg8::gemm_phase<pg8::EpiMkv, pg8::SingleOrder, false, true>(F.lds + RING_OFF, g, S, E);
        return;
    }
    int rank = F.vcu; { int below = 0; for (int pb = 0; pb < NPROD; ++pb) { const int pv = (F.G % 8 == 0) ? (pb % 8) * (F.G / 8) + pb / 8 : pb; below += (pv < F.vcu) ? 1 : 0; } rank -= below; }
    const int gw = rank * NWAVES + F.wave, NGW = (F.G - NPROD) * NWAVES;
    LAS float* scr = (LAS float*)(F.lds + RING_OFF + F.wave * 16384);
    constexpr int I_W1 = 32 * (NP / 32), I_MKV = 32 * 32, I_BR = 32 * 64, I_OUT = 32 * 64, NITEMS = I_W1 + I_BR + I_OUT;
    { f32x4 gm[8];
#pragma unroll
      for (int j = 0; j < 8; ++j) gm[j] = ((const f32x4*)mem_norm_gain)[F.lane + 64 * j];
      for (int m = gw; m < MM; m += NGW) { f32x4 vm[8]; rms_row_load(vm, mem + (size_t)m * DM, F.lane); rms_row<false>(vm, gm, MEMN + (size_t)m * DM, F.lane, nullptr, 0.f, nullptr); }
      for (int r = gw; r < I_MKV; r += NGW) { const int kb = r / 32, nb = r % 32, k0 = 64 * kb, n0 = 32 * nb; f32x4 vv[8];
          p0_item_load(vv, w_mem_kv + (size_t)k0 * 1024 + n0, 1024, F.lane); p0_item_finish(vv, WMKVT + (size_t)n0 * DM + k0, DM, scr, F.lane); } }
    VM_WAIT(); __syncthreads();
    if (F.tid == 0) { __builtin_amdgcn_fence(__ATOMIC_RELEASE, "agent"); VM_WAIT(); __hip_atomic_fetch_add((unsigned*)p0c, 1u, __ATOMIC_RELAXED, __HIP_MEMORY_SCOPE_AGENT); }
    if ((PROBE_REPEAT == 73 || PROBE_REPEAT == 90) && args.pad) return;
    const bool swp = P0_SWAP && ((((int)blockIdx.x >> 3) & 1) != 0);
    auto do_rows = [&]() {
    LAS float* wfb = (LAS float*)(F.lds + RING_OFF);
    { f32x4 pv[12];
#pragma unroll
      for (int i = 0; i < 12; ++i) { const int pc = F.tid + i * (NWAVES * 64), k = pc / 3, part = pc % 3; pv[i] = *(const f32x4*)(w_in + (size_t)k * IN_W + SRC_FB + 4 * part); }
#pragma unroll
      for (int i = 0; i < 12; ++i) { const int pc = F.tid + i * (NWAVES * 64), k = pc / 3, part = pc % 3; LAS float* d = wfb + (4 * part) * DM + k; d[0] = pv[i].x; d[DM] = pv[i].y; d[2 * DM] = pv[i].z; d[3 * DM] = pv[i].w; } }
    __syncthreads();
    if ((PROBE_REPEAT == 74 || PROBE_REPEAT == 91) && args.pad) return;
    { f32x4 gn[8];
#pragma unroll
      for (int j = 0; j < 8; ++j) gn[j] = ((const f32x4*)norm_gain)[F.lane + 64 * j];
      const float bfl = (F.lane < 12) ? b_forget[F.lane] : 0.f;
      { constexpr int NR = M * (PROBE_REPEAT == 0 ? 2 : 1);
        f32x4 va[8], vb[8];
        if (gw < NR) rms_row_load(va, x + (size_t)(gw % M) * DM, F.lane);
        for (int mm = gw; mm < NR; mm += 2 * NGW) {
            const bool h1 = mm + NGW < NR;
            if (h1) rms_row_load(vb, x + (size_t)((mm + NGW) % M) * DM, F.lane);
            { const int m = mm % M, b = m / SEQ, t = m % SEQ; rms_row<true>(va, gn, HN + (size_t)m * DM, F.lane, (const LAS f32x4*)wfb, bfl, LF + (size_t)b * 12 * SEQ + t); }
            if (!h1) break;
            const bool h2 = mm + 2 * NGW < NR;
            if (h2) rms_row_load(va, x + (size_t)((mm + 2 * NGW) % M) * DM, F.lane);
            { const int m = (mm + NGW) % M, b = m / SEQ, t = m % SEQ; rms_row<true>(vb, gn, HN + (size_t)m * DM, F.lane, (const LAS f32x4*)wfb, bfl, LF + (size_t)b * 12 * SEQ + t); }
            if (!h2) break;
        } }
    }
    __syncthreads();
    if ((PROBE_REPEAT == 75 || PROBE_REPEAT == 92) && args.pad) return;
    };
    auto do_items = [&]() {
    auto item_addr = [&](int it, const float*& src, int& ldw, bf16*& dst) {
        int r = it % NITEMS;
        if (r < I_W1) { const int kb = r / (NP / 32), nb = r % (NP / 32), k0 = 64 * kb, n0 = 32 * nb, sn = n0 + (n0 >= SRC_FB ? 12 : 0); src = w_in + (size_t)k0 * IN_W + sn; ldw = IN_W; dst = W1T + (size_t)n0 * DM + k0; return; } r -= I_W1;
        if (r < I_BR) { const int kb = r / 64, nb = r % 64, k0 = 64 * kb, n0 = 32 * nb;
            src = ((kb < 12) ? w_br_a + (size_t)k0 * DM : (kb < 24) ? w_br_b + (size_t)(k0 - 768) * DM : w_br_c + (size_t)(k0 - 1536) * DM) + n0; ldw = DM; dst = WBRT + (size_t)n0 * DM + k0; return; } r -= I_BR;
        { const int kb = r / 64, nb = r % 64, k0 = 64 * kb, n0 = 32 * nb; src = w_out + (size_t)k0 * DM + n0; ldw = DM; dst = WOUTT + (size_t)n0 * DM + k0; }
    };
    constexpr int NIT = NITEMS * (PROBE_REPEAT == 0 ? 2 : 1);
    const int gwi = (gw + NGW - (M % NGW)) % NGW;
    if (gwi < NIT) {
        f32x4 va[8], vb[8], vc[8]; const float* src; int ldw; bf16* da = nullptr; bf16* db = nullptr; bf16* dc = nullptr;
        item_addr(gwi, src, ldw, da); p0_item_load(va, src, ldw, F.lane);
        if (gwi + NGW < NIT) { item_addr(gwi + NGW, src, ldw, db); p0_item_load(vb, src, ldw, F.lane); }
        for (int it = gwi; it < NIT; it += 3 * NGW) {
            if (it + 2 * NGW < NIT) { item_addr(it + 2 * NGW, src, ldw, dc); p0_item_load(vc, src, ldw, F.lane); }
            p0_item_finish(va, da, DM, scr, F.lane);
            if (it + NGW >= NIT) break;
            if (it + 3 * NGW < NIT) { item_addr(it + 3 * NGW, src, ldw, da); p0_item_load(va, src, ldw, F.lane); }
            p0_item_finish(vb, db, DM, scr, F.lane);
            if (it + 2 * NGW >= NIT) break;
            if (it + 4 * NGW < NIT) { item_addr(it + 4 * NGW, src, ldw, db); p0_item_load(vb, src, ldw, F.lane); }
            p0_item_finish(vc, dc, DM, scr, F.lane);
        }
    }
    };
    if (swp) { do_items(); __syncthreads(); do_rows(); } else { do_rows(); do_items(); }
}
__device__ __forceinline__ void cumsum_bh(Frame& F, const float* LF, float* CS2, int* T0TAB, int bh, float fox_thr) {
    const float* src = LF + (size_t)bh * SEQ + F.tid * 8; float* dst = CS2 + (size_t)bh * SEQ + F.tid * 8;
    const f32x4 a = *(const f32x4*)src, b = *(const f32x4*)(src + 4);
    float v[8]; v[0] = a.x; v[1] = v[0] + a.y; v[2] = v[1] + a.z; v[3] = v[2] + a.w; v[4] = v[3] + b.x; v[5] = v[4] + b.y; v[6] = v[5] + b.z; v[7] = v[6] + b.w;
    float incl = v[7];
#define CS_DPP(ctrl, rmask) incl += __builtin_bit_cast(float, __builtin_amdgcn_update_dpp(0, __builtin_bit_cast(int, incl), ctrl, rmask, 0xf, false))
    CS_DPP(0x111, 0xf); CS_DPP(0x112, 0xf); CS_DPP(0x114, 0xf); CS_DPP(0x118, 0xf); CS_DPP(0x142, 0xa); CS_DPP(0x143, 0xc);
#undef CS_DPP
    if (F.lane == 63) F.MISC[16 + F.wave] = __builtin_bit_cast(unsigned, incl);
    __syncthreads();
    float off = incl - v[7];
    { float t[7];
#pragma unroll
      for (int w = 0; w < 7; ++w) t[w] = __builtin_bit_cast(float, (unsigned)F.MISC[16 + w]);
#pragma unroll
      for (int w = 0; w < 7; ++w) off += (w < F.wave) ? t[w] : 0.f; }
    f32x4 o0, o1; o0.x = (v[0] + off) * LOG2E; o0.y = (v[1] + off) * LOG2E; o0.z = (v[2] + off) * LOG2E; o0.w = (v[3] + off) * LOG2E;
    o1.x = (v[4] + off) * LOG2E; o1.y = (v[5] + off) * LOG2E; o1.z = (v[6] + off) * LOG2E; o1.w = (v[7] + off) * LOG2E;
    *(f32x4*)dst = o0; *(f32x4*)(dst + 4) = o1;
    LAS float* csl = (LAS float*)(F.lds + RING_OFF);
    *(LAS f32x4*)(csl + F.tid * 8) = o0; *(LAS f32x4*)(csl + F.tid * 8 + 4) = o1;
    __syncthreads();
#pragma unroll
    for (int e = 0; e < 2; ++e) { const int qb = F.wave * 2 + e, nb = 4 * qb; const float cq0 = csl[256 * qb];
        const bool fails = (F.lane < nb) && !(cq0 - csl[64 * F.lane + 63] >= -fox_thr);
        const unsigned long long mk = __ballot(fails);
        if (F.lane == 0) T0TAB[bh * 16 + qb] = __popcll(mk); }
    __syncthreads();
}

constexpr int N_PHASES = 5;
__global__ void __launch_bounds__(NWAVES * 64, 2) mega_fwd(Args args) {
    extern __shared__ __attribute__((aligned(16))) unsigned char lds[];
    Frame F;
    F.lds = (LAS unsigned char*)lds;
    F.MISC = (volatile LAS unsigned*)(F.lds + MISC_OFF);
    F.tid = threadIdx.x; F.lane = F.tid & 63; F.wave = __builtin_amdgcn_readfirstlane(F.tid >> 6);
    F.G = gridDim.x; { const int bx = blockIdx.x; F.vcu = (F.G % 8 == 0) ? (bx % 8) * (F.G / 8) + bx / 8 : bx; }
    unsigned char* ws = args.ws;
    F.ctl = (gu32*)(ws + WS_CTL);
    for (int u = F.tid; u < (LDS_BYTES - LDSCTL_OFF) / 4; u += NWAVES * 64) ((LAS unsigned*)(F.lds + LDSCTL_OFF))[u] = 0u;
    __syncthreads();
    const int lo = args.ph_lo, hi = args.ph_hi;
    XcdBarrier bar; bar.bar = (unsigned*)(F.ctl + CW_BAR) + args.li * XCD_BAR_WORDS; bar.x = 0; bar.st = nullptr;
    if (hi - lo > 1) bar = xcd_barrier_post((unsigned*)(F.ctl + CW_BAR) + args.li * XCD_BAR_WORDS, F.MISC + 8);
#define IN(k) (lo <= (k) && (k) < hi)
#define BOTH(k) (IN(k) && IN((k) + 1))
#define GRID_BAR() do { xcd_barrier(bar); if (PROBE_REPEAT == 6) { xcd_barrier(bar); xcd_barrier(bar); } } while (0)
    bf16* HN = (bf16*)(ws + WS_HN); bf16* MEMN = (bf16*)(ws + WS_MEMN); bf16* MKV = (bf16*)(ws + WS_MKV); bf16* PG = (bf16*)(ws + WS_PG); bf16* U = W1T_IN_OUT ? (bf16*)args.out : (bf16*)(ws + WS_U); bf16* Y = (bf16*)(ws + WS_Y);
    bf16* QA = (bf16*)(ws + WS_QA); bf16* ZA = (bf16*)(ws + WS_ZA); bf16* QB = (bf16*)(ws + WS_QB); bf16* ZB = (bf16*)(ws + WS_ZB); bf16* KB = (bf16*)(ws + WS_KB); bf16* VB = (bf16*)(ws + WS_VB); bf16* KA = (bf16*)(ws + WS_KA); bf16* VA = (bf16*)(ws + WS_VA);
    bf16* W1T = W1T_IN_OUT ? (bf16*)args.out : (bf16*)(ws + WS_W1T); bf16* WMKVT = (bf16*)(ws + WS_WMKVT); bf16* WBRT = (bf16*)(ws + WS_WBRT); bf16* WOUTT = (bf16*)(ws + WS_WOUTT);
    float* CS2 = (float*)(ws + WS_CS2); float* LF = (float*)(ws + WS_LF); int* T0TAB = (int*)(ws + WS_T0);

#if TLB_TOUCH
    if (IN(0)) {
        const size_t gt = (size_t)blockIdx.x * (NWAVES * 64) + F.tid; const size_t off = gt << 21; const unsigned dl = (unsigned)(size_t)(F.lds + T0L_OFF + 4800);
        if (off < (size_t)M * DM * 4) { att::glds4(args.in[0] + (off >> 2), dl); att::glds4(args.out + (off >> 2), dl); }
        if (off < (size_t)DM * IN_W * 4) att::glds4(args.in[4] + (off >> 2), dl);
        if (off < (size_t)DM * DM * 4) att::glds4(args.in[17] + (off >> 2), dl);
        if (off < WS_END) att::glds4(ws + off, dl);
    }
#endif
    if (IN(0)) { p0_prologue(F, args); if (BOTH(0)) GRID_BAR(); }

    if (IN(1)) {
        if (((int)blockIdx.x & 1) && (int)blockIdx.x < 2 * BATCH * 12) {
            float gq = fabsf(args.in[9][F.lane]), gk = fabsf(args.in[10][F.lane]);
#pragma unroll
            for (int o = 1; o < 64; o <<= 1) { gq = fmaxf(gq, __shfl_xor(gq, o)); gk = fmaxf(gk, __shfl_xor(gk, o)); }
            cumsum_bh(F, LF, CS2, T0TAB, (int)blockIdx.x >> 1, 2.f * (64.f * C2_64 * gq * gk * 1.02f) + 40.f); }
        { pg8::Gemm g{HN, W1T, M, NP, DM}; pg8::StaticOrder S; S.init(M, NP, F.G, (int)blockIdx.x); S.rep = (PROBE_REPEAT == 1) ? 2 : 1; S.wgm = P1_WGM; S.mix = P1_MIX;
          pg8::EpiProj E{PG, QA, ZA, QB, ZB, KB, VB, KA, VA, args.in[6], args.in[7], args.in[9], args.in[10], C2_64, EPS, GATE_MIN};
          pg8::gemm_phase<pg8::EpiProj, pg8::StaticOrder, P1_ALIGN, P1_SP2>(F.lds + RING_OFF, g, S, E);
#if PROBE_REPEAT == 21
          { pg8::EpiPlain E2{(bf16*)(ws + WS_END + 2 * MiB), DM};
            pg8::gemm_phase<pg8::EpiPlain, pg8::StaticOrder, P1_ALIGN, P1_SP2>(F.lds + RING_OFF, g, S, E2); }
#endif
        }
        if (BOTH(1)) GRID_BAR();
    }
    if (IN(2)) {
        gu32* mkf = F.ctl + CW_MKF;
        LAS int* t0l = (LAS int*)(F.lds + T0L_OFF);
        for (int i2 = F.tid; i2 < 384; i2 += NWAVES * 64) t0l[i2] = T0TAB[i2];
        if (F.tid < 12) ((LAS float*)t0l)[1160 + F.tid] = args.in[8][F.tid];
#if PROBE_REPEAT == 50 || PROBE_REPEAT == 67
#ifndef PROBE_FORCE_NT
#define PROBE_FORCE_NT 0
#endif
        if (F.tid == 0) t0l[1152] = args.pad ? PROBE_FORCE_NT : 0;
#endif
        __syncthreads();
        if (LPT_SORT) {
            if (F.tid < 384) { const int bh = F.tid % 24, qb = 15 - F.tid / 24; t0l[768 + F.tid] = qb * 4 + 4 - t0l[bh * 16 + qb]; }
            __syncthreads();
            if (F.tid < 384) { const int my = t0l[768 + F.tid]; int rank = 0;
                for (int j = 0; j < 384; j += 4) { typedef int i32x4_ __attribute__((ext_vector_type(4))); const i32x4_ v = *(const LAS i32x4_*)(t0l + 768 + j);
                    rank += (v.x > my || (v.x == my && j < F.tid)) + (v.y > my || (v.y == my && j + 1 < F.tid)) + (v.z > my || (v.z == my && j + 2 < F.tid)) + (v.w > my || (v.w == my && j + 3 < F.tid)); }
                t0l[384 + rank] = F.tid; }
        }
        constexpr int n_total = att::N_UNITS * (PROBE_REPEAT == 2 ? 2 : 1) + (PROBE_REPEAT == 7 ? 384 : 0) + (PROBE_REPEAT == 8 ? 384 : 0) + (PROBE_REPEAT == 11 ? 128 : 0) + ((PROBE_REPEAT == 12 || PROBE_REPEAT == 13 || PROBE_REPEAT == 14 || (PROBE_REPEAT >= 40 && PROBE_REPEAT < 50)) ? 384 : 0);
#if PROBE_REPEAT >= 50 && PROBE_REPEAT < 70
        const unsigned q_lo = (unsigned)args.pad & 0xffffu; const int n_tot_rt = (args.pad >> 16) ? (args.pad >> 16) : n_total;
#define n_total n_tot_rt
#define P2_WINDOW 1
#else
        const unsigned q_lo = STATIC_FIRST ? (unsigned)F.G : 0u;
#endif
        att::Tensors T{ws, args.in[8], args.in[11], args.in[12], (const LAS int*)t0l, (const unsigned*)mkf, args.pad, (unsigned*)(F.ctl + CW_Q), q_lo, (unsigned short*)U};
#if defined(P2_WINDOW) || !STATIC_FIRST
        if (F.tid == 0) { const unsigned q = __hip_atomic_fetch_add((unsigned*)(F.ctl + CW_Q), 1u, __ATOMIC_RELAXED, __HIP_MEMORY_SCOPE_AGENT) + q_lo;
            F.MISC[24] = q; }
        __syncthreads();
        int cu = __builtin_amdgcn_readfirstlane((int)F.MISC[24]);
#else
        int cu = (int)blockIdx.x;
#endif
        if (cu < n_total) {
            att::Desc cur = att::decode(PROBE_MAP(cu), T.t0tab);
            { const att::Geo g0 = att::geo(T, cur); att::issue_head(T, g0, cur, (unsigned)(size_t)(F.lds + RING_OFF), F.wave, F.lane); att::issue_rest(g0, cur, (unsigned)(size_t)(F.lds + RING_OFF), F.wave, F.lane); }
            for (;;) {
                const unsigned nidx = 0u;
                int nu; att::Desc nd = cur;
#if PROBE_REPEAT >= 40 && PROBE_REPEAT < 50
                if (cur.kind == 1 && cur.dummy) att::unit<1, PROBE_REPEAT>(T, cur, F.lds + RING_OFF, F.MISC, nidx, n_total, nu, nd); else
#endif
                if (cur.kind == 1) att::unit<1>(T, cur, F.lds + RING_OFF, F.MISC, nidx, n_total, nu, nd);
                else if (cur.kind == 2) att::unit<2>(T, cur, F.lds + RING_OFF, F.MISC, nidx, n_total, nu, nd);
                else att::unit<0>(T, cur, F.lds + RING_OFF, F.MISC, nidx, n_total, nu, nd);
                if (nu >= n_total) break;
                cur = nd;
            }
        }
        VM_WAIT();
#if PROBE_REPEAT >= 50 && PROBE_REPEAT < 70
#undef n_total
#endif
        if (BOTH(2)) GRID_BAR();
    }
    if (IN(3)) {
        pg8::Gemm g{U, WBRT, M, DM, DM}; pg8::StaticOrder S; S.init(M, DM, F.G, (int)blockIdx.x); S.rep = (PROBE_REPEAT == 3) ? 2 : 1; S.wgm = P34_WGM;
        pg8::EpiGate E{PG + (size_t)M * PGW, Y, DM};
        pg8::gemm_phase<pg8::EpiGate, pg8::StaticOrder, true, true>(F.lds + RING_OFF, g, S, E);
#if PROBE_REPEAT == 23
        { pg8::EpiPlain E2{(bf16*)(ws + WS_END + 2 * MiB), DM}; pg8::gemm_phase<pg8::EpiPlain, pg8::StaticOrder, true, true>(F.lds + RING_OFF, g, S, E2); }
#endif
        if (BOTH(3)) GRID_BAR();
    }
    if (IN(4)) {
        pg8::Gemm g{Y, WOUTT, M, DM, DM}; pg8::StaticOrder S; S.init(M, DM, F.G, (int)blockIdx.x); S.rep = (PROBE_REPEAT == 4) ? 2 : 1; S.wgm = P34_WGM;
        pg8::EpiOut E{args.in[0], args.out, DM};
        pg8::gemm_phase<pg8::EpiOut, pg8::StaticOrder, true, true>(F.lds + RING_OFF, g, S, E);
    }
#undef IN
#undef BOTH
#undef GRID_BAR
}

static int launch_mega(Args a, int lo, int hi, int li, int grid, hipStream_t stream, int pad = 0) {
    a.ph_lo = lo; a.ph_hi = hi; a.li = li; a.pad = pad;
    hipLaunchKernelGGL(mega_fwd, dim3(grid), dim3(NWAVES * 64), LDS_BYTES, stream, a);
    const hipError_t le = hipPeekAtLastError();
    if (le != hipSuccess) { fprintf(stderr, "kernel_launch: launch [%d,%d) failed: %s\n", lo, hi, hipGetErrorName(le)); return -1; }
    return 0;
}
extern "C" void kernel_launch(void* const* d_in, const int* in_sizes, int n_in, void* d_out, int out_size, void* d_ws_, size_t ws_size, hipStream_t stream) {
    void* d_ws = (WS_TOP && ws_size > WS_END + 8 * MiB) ? (void*)((char*)d_ws_ + ((ws_size - WS_END - WS_SLACK) & ~(size_t)(2 * MiB - 1))) : d_ws_;
    static int grid = 0;
    if (grid == 0) {
        if (n_in != 18 || in_sizes[0] != M * DM || out_size != M * DM || ws_size < WS_END) { fprintf(stderr, "kernel_launch: unexpected shapes (n_in %d, in0 %d, out %d, ws %zu)\n", n_in, n_in > 0 ? in_sizes[0] : -1, out_size, ws_size); grid = -1; return; }
        int dev = 0, cus = 0, per_cu = 0;
        if (hipGetDevice(&dev) != hipSuccess || hipDeviceGetAttribute(&cus, hipDeviceAttributeMultiprocessorCount, dev) != hipSuccess) { fprintf(stderr, "kernel_launch: device query failed\n"); grid = -1; return; }
        if (hipFuncSetAttribute((const void*)mega_fwd, hipFuncAttributeMaxDynamicSharedMemorySize, LDS_BYTES) != hipSuccess) { fprintf(stderr, "kernel_launch: hipFuncSetAttribute failed\n"); grid = -1; return; }
        if (hipOccupancyMaxActiveBlocksPerMultiprocessor(&per_cu, (const void*)mega_fwd, NWAVES * 64, LDS_BYTES) != hipSuccess || per_cu < 1) { fprintf(stderr, "kernel_launch: occupancy query reports %d workgroups per CU; not launching\n", per_cu); (void)hipGetLastError(); grid = -1; return; }
        grid = cus;
        if (grid < 64) { fprintf(stderr, "kernel_launch: %d compute units: this phase program expects a full MI355X (eight producer workgroups beside the others)\n", grid); grid = -1; return; }
    }
    if (grid < 0) return;
    if (hipMemsetAsync((char*)d_ws + WS_CTL, 0, CTL_ZERO_BYTES, stream) != hipSuccess) { fprintf(stderr, "kernel_launch: memset failed\n"); return; }
    Args a{};
    for (int i = 0; i < 18; ++i) a.in[i] = (const float*)d_in[i];
    a.out = (float*)d_out; a.ws = (unsigned char*)d_ws;
    unsigned char* ws = (unsigned char*)d_ws;
    bf16* MKV = (bf16*)(ws + WS_MKV); bf16* PG = (bf16*)(ws + WS_PG); bf16* U = (bf16*)(ws + WS_U); bf16* Y = (bf16*)(ws + WS_Y);
    bf16* QA = (bf16*)(ws + WS_QA); bf16* ZA = (bf16*)(ws + WS_ZA); bf16* QB = (bf16*)(ws + WS_QB); bf16* ZB = (bf16*)(ws + WS_ZB); bf16* KB = (bf16*)(ws + WS_KB); bf16* VB = (bf16*)(ws + WS_VB); bf16* KA = (bf16*)(ws + WS_KA); bf16* VA = (bf16*)(ws + WS_VA); float* CS2 = (float*)(ws + WS_CS2);
    const float* sinks_a = (const float*)d_in[8]; const float* q_gain_c = (const float*)d_in[11]; const float* k_gain_c = (const float*)d_in[12];
#if PROBE_REPEAT >= 90 && PROBE_REPEAT <= 93
    if (launch_mega(a, 0, 1, 0, grid, stream, 1)) return;
    if (hipMemsetAsync((char*)d_ws + WS_CTL, 0, CTL_ZERO_BYTES, stream) != hipSuccess) return;
#endif
#if PROBE_REPEAT >= 35 && PROBE_REPEAT <= 38
    if (launch_mega(a, 0, PROBE_REPEAT - 34, 0, grid, stream)) return;
    if (hipMemsetAsync((char*)d_ws + WS_CTL, 0, CTL_ZERO_BYTES, stream) != hipSuccess) return;
#endif
    if (launch_mega(a, 0, N_PHASES, 0, grid, stream)) return;
#if PROBE_REPEAT >= 30 && PROBE_REPEAT <= 34
    if (hipMemsetAsync((char*)d_ws + WS_CTL, 0, CTL_ZERO_BYTES, stream) != hipSuccess) return;
    if (launch_mega(a, 0, PROBE_REPEAT - 30, 0, grid, stream)) return;
#endif
#if PROBE_REPEAT >= 50 && PROBE_REPEAT < 70
    if (hipMemsetAsync((char*)d_ws + WS_CTL, 0, CTL_ZERO_BYTES, stream) != hipSuccess) return;
    if (launch_mega(a, 0, 3, 0, grid, stream, PROBE_REPEAT == 50 ? ((PROBE_WIN_HI << 16) | PROBE_WIN_LO) : PROBE_REPEAT == 51 ? (384 << 16) : PROBE_REPEAT == 52 ? ((896 << 16) | 384) : PROBE_REPEAT == 58 ? (256 << 16) : PROBE_REPEAT == 59 ? ((384 << 16) | 256) : PROBE_REPEAT == 67 ? (1024 << 16) : PROBE_REPEAT >= 60 ? ((1408 << 16) | 384) : (PROBE_REPEAT == 53 || (PROBE_REPEAT >= 55 && PROBE_REPEAT < 58)) ? ((576 << 16) | 384) : PROBE_REPEAT == 54 ? ((704 << 16) | 576) : 0)) return;
#endif
#if PROBE_REPEAT >= 71 && PROBE_REPEAT <= 76
    if (hipMemsetAsync((char*)d_ws + WS_CTL, 0, CTL_ZERO_BYTES, stream) != hipSuccess) return;
    if (launch_mega(a, 0, 1, 0, grid, stream, 1)) return;
#endif
#if PROBE_REPEAT == 81
    for (int rep = 0; rep < 4; ++rep) {
        if (hipMemsetAsync((char*)d_ws + WS_CTL, 0, CTL_ZERO_BYTES, stream) != hipSuccess) return;
        if (launch_mega(a, 0, 1, 0, grid, stream, 1)) return; }
#endif
#if PROBE_REPEAT == 80
    for (int rep = 0; rep < 4; ++rep) {
        if (hipMemsetAsync((char*)d_ws + WS_CTL, 0, CTL_ZERO_BYTES, stream) != hipSuccess) return;
        if (launch_mega(a, 2, 3, 0, grid, stream, 0)) return; }
#endif
#if PROBE_REPEAT == 20
    if (hipMemsetAsync((char*)d_ws + WS_CTL, 0, CTL_ZERO_BYTES, stream) != hipSuccess) return;
    if (launch_mega(a, 0, N_PHASES, 0, grid, stream)) return;
#endif
}
```
